# Optimizing an MI355X kernel written in HIP

```python
import math
import jax
import jax.numpy as jnp
from jax import lax
import numpy as np

D_MODEL = 1024
BATCH = 4
SEQ = 4096
DEPTH = 2

EPS = 1e-6
ROPE_THETA = 10000.0
MIX_WIDTH = 1024
RET_HEADS = 4
RET_HEAD_DIM = 128
RET_WIDTH = RET_HEADS * RET_HEAD_DIM
RET_CHUNK = 128
HGRN_HEADS = 4
HGRN_DK = 128
HGRN_DV = 128
HGRN_WIDTH = HGRN_HEADS * HGRN_DK
HGRN_CHUNK = 64
AB_IN = 4 * RET_WIDTH + 4 * HGRN_WIDTH
SB_HEADS = 4
SB_HEAD_DIM = 128
SB_WIDTH = SB_HEADS * SB_HEAD_DIM
DIFF_HEADS = 4
DIFF_QK_DIM = 64
DIFF_V_DIM = 128
DIFF_WIDTH = DIFF_HEADS * DIFF_V_DIM
CD_IN = 3 * SB_WIDTH + 3 * DIFF_WIDTH
Q_BLOCK = 128
N_GROUPS = 4
EXPERTS_PER_GROUP = 8
N_EXPERTS = N_GROUPS * EXPERTS_PER_GROUP
TOP_K = 2
EXPERT_FF = 512
ROW_BLOCK = 256

kernel_name = "hybrid_ret_hgrn2_stickbreak_diffattn_hiermoe"

F32 = jnp.float32


def rms_norm(x, gain):
    xf = x.astype(F32)
    y = xf * lax.rsqrt(jnp.mean(xf * xf, axis=-1, keepdims=True) + EPS)
    return (y * gain.astype(F32)).astype(x.dtype)


def rope_tables(positions, dim):
    inv = 1.0 / (ROPE_THETA ** (jnp.arange(0, dim, 2, dtype=F32) / dim))
    ang = positions.astype(F32)[..., None] * inv
    return jnp.cos(ang), jnp.sin(ang)


def apply_rope(x, cos, sin):
    xf = x.astype(F32)
    half = xf.shape[-1] // 2
    x1, x2 = xf[..., :half], xf[..., half:]
    return jnp.concatenate([x1 * cos - x2 * sin, x2 * cos + x1 * sin], axis=-1)


def _chunks(t, n, c):
    b, s, h, d = t.shape
    return t.astype(F32).reshape(b, n, c, h, d).transpose(1, 0, 3, 2, 4)


def retention_chunkwise(q, k, v):
    B, S, H, d = q.shape
    C = RET_CHUNK
    N = S // C
    log_gamma = jnp.log(1.0 - 2.0 ** (-5.0 - jnp.arange(H, dtype=F32)))
    qc = _chunks(q, N, C) * (d ** -0.5)
    kc = _chunks(k, N, C)
    vc = _chunks(v, N, C)
    idx = jnp.arange(C, dtype=F32)
    rel = idx[:, None] - idx[None, :]
    decay = jnp.where(rel >= 0, jnp.exp(log_gamma[:, None, None] * jnp.maximum(rel, 0.0)), 0.0)
    q_decay = jnp.exp(log_gamma[:, None] * (idx + 1.0))[:, :, None]
    k_decay = jnp.exp(log_gamma[:, None] * (C - 1.0 - idx))[:, :, None]
    chunk_decay = jnp.exp(log_gamma * C)[:, None, None]

    def step(state, inp):
        qi, ki, vi = inp
        scores = jnp.einsum('bhtd,bhsd->bhts', qi, ki) * decay
        inner = jnp.einsum('bhts,bhse->bhte', scores, vi)
        cross = jnp.einsum('bhtd,bhde->bhte', qi, state) * q_decay
        state = state * chunk_decay + jnp.einsum('bhsd,bhse->bhde', ki * k_decay, vi)
        return state, inner + cross

    state0 = jnp.zeros((B, H, d, v.shape[-1]), F32)
    _, out = lax.scan(step, state0, (qc, kc, vc))
    return out.transpose(1, 0, 3, 2, 4).reshape(B, S, H, -1)


def hgrn2_chunkwise(q, k, v, log_f):
    B, S, H, dk = q.shape
    C = HGRN_CHUNK
    N = S // C
    qc = _chunks(q, N, C) * (dk ** -0.5)
    kc = _chunks(k, N, C)
    vc = _chunks(v, N, C)
    gc = _chunks(log_f, N, C)
    causal = jnp.tril(jnp.ones((C, C), dtype=bool))[:, :, None]

    def step(state, inp):
        qi, ki, vi, gi = inp
        b = jnp.cumsum(gi, axis=2)
        diff = b[:, :, :, None, :] - b[:, :, None, :, :]
        w = jnp.exp(jnp.where(causal, diff, -jnp.inf))
        scores = jnp.einsum('bhtd,bhtsd->bhts', qi, w * ki[:, :, None, :, :])
        inner = jnp.einsum('bhts,bhse->bhte', scores, vi)
        cross = jnp.einsum('bhtd,bhde->bhte', qi * jnp.exp(b), state)
        b_last = b[:, :, -1:, :]
        state = state * jnp.swapaxes(jnp.exp(b_last), 2, 3) + jnp.einsum(
            'bhsd,bhse->bhde', ki * jnp.exp(b_last - b), vi)
        return state, inner + cross

    state0 = jnp.zeros((B, H, dk, v.shape[-1]), F32)
    _, out = lax.scan(step, state0, (qc, kc, vc, gc))
    return out.transpose(1, 0, 3, 2, 4).reshape(B, S, H, -1)


def stick_breaking_attention(q, k, v):
    S = q.shape[2]
    scale = q.shape[-1] ** -0.5
    outs = []
    for i0 in range(0, S, Q_BLOCK):
        i1 = i0 + Q_BLOCK
        z = jnp.einsum('bhqd,bhkd->bhqk', q[:, :, i0:i1], k[:, :, :i1]).astype(F32) * scale
        mask = jnp.arange(i1)[None, :] < jnp.arange(i0, i1)[:, None]
        log_beta = jax.nn.log_sigmoid(z)
        log_1mb = jnp.where(mask, jax.nn.log_sigmoid(-z), 0.0)
        after = lax.cumsum(log_1mb, axis=3, reverse=True) - log_1mb
        a = jnp.where(mask, jnp.exp(log_beta + after), 0.0)
        outs.append(jnp.einsum('bhqk,bhkd->bhqd', a, v[:, :, :i1].astype(F32)))
    return jnp.concatenate(outs, axis=2)


def differential_attention(q, k, v, lam):
    S = q.shape[3]
    scale = q.shape[-1] ** -0.5
    outs = []
    for i0 in range(0, S, Q_BLOCK):
        i1 = i0 + Q_BLOCK
        s = jnp.einsum('bhcqd,bhckd->bhcqk', q[:, :, :, i0:i1], k[:, :, :, :i1]).astype(F32) * scale
        mask = jnp.arange(i1)[None, :] <= jnp.arange(i0, i1)[:, None]
        p = jax.nn.softmax(jnp.where(mask, s, -jnp.inf), axis=-1)
        a = p[:, :, 0] - lam * p[:, :, 1]
        outs.append(jnp.einsum('bhqk,bhkd->bhqd', a, v[:, :, :i1].astype(F32)))
    return jnp.concatenate(outs, axis=2)


def retention_hgrn2_mixer(h, w_in, w_out, ret_gain, lb, hgrn_gain, cos, sin):
    B, S, _ = h.shape
    proj = h @ w_in
    rq, rk, rv, rg, hq, hf, hi, hg = jnp.split(proj, 8, axis=-1)
    rshape = (B, S, RET_HEADS, RET_HEAD_DIM)
    rq = apply_rope(rq.reshape(rshape), cos[:, :, None], sin[:, :, None])
    rk = apply_rope(rk.reshape(rshape), cos[:, :, None], sin[:, :, None])
    ret = retention_chunkwise(rq, rk, rv.reshape(rshape))
    ret = rms_norm(ret, ret_gain).reshape(B, S, RET_WIDTH) * jax.nn.silu(rg.astype(F32))
    hshape = (B, S, HGRN_HEADS, HGRN_DK)
    lb = lb.reshape(HGRN_HEADS, HGRN_DK)
    f_raw = hf.astype(F32).reshape(hshape)
    log_f = jnp.log(lb + (1.0 - lb) * jax.nn.sigmoid(f_raw))
    hk = (1.0 - lb) * jax.nn.sigmoid(-f_raw)
    hq = jax.nn.silu(hq.astype(F32)).reshape(hshape)
    hv = hi.astype(F32).reshape(B, S, HGRN_HEADS, HGRN_DV)
    o = hgrn2_chunkwise(hq, hk, hv, log_f)
    o = rms_norm(o, hgrn_gain).reshape(B, S, HGRN_HEADS * HGRN_DV) * jax.nn.silu(hg.astype(F32))
    mixed = jnp.concatenate([ret, o], axis=-1).astype(h.dtype)
    return mixed @ w_out


def stickbreak_diff_mixer(h, w_in, w_out, q_gain, k_gain, lq1, lk1, lq2, lk2, subln, cos, sin, layer_idx):
    B, S, _ = h.shape
    proj = h @ w_in
    sq, sk, sv, dq, dk, dv = jnp.split(proj, 6, axis=-1)
    sshape = (B, S, SB_HEADS, SB_HEAD_DIM)
    sq, sk, sv = [t.reshape(sshape).transpose(0, 2, 1, 3) for t in (sq, sk, sv)]
    sb = stick_breaking_attention(sq, sk, sv)
    sb = sb.transpose(0, 2, 1, 3).reshape(B, S, SB_WIDTH)
    dshape = (B, S, DIFF_HEADS, 2, DIFF_QK_DIM)
    dq = apply_rope(rms_norm(dq.reshape(dshape), q_gain), cos[:, :, None, None], sin[:, :, None, None])
    dk = apply_rope(rms_norm(dk.reshape(dshape), k_gain), cos[:, :, None, None], sin[:, :, None, None])
    dq = dq.transpose(0, 2, 3, 1, 4)
    dk = dk.transpose(0, 2, 3, 1, 4)
    dv = dv.reshape(B, S, DIFF_HEADS, DIFF_V_DIM).transpose(0, 2, 1, 3)
    lam_init = 0.8 - 0.6 * math.exp(-0.3 * layer_idx)
    lam = (jnp.exp(jnp.sum(lq1.astype(F32) * lk1.astype(F32)))
           - jnp.exp(jnp.sum(lq2.astype(F32) * lk2.astype(F32))) + lam_init)
    da = differential_attention(dq, dk, dv, lam)
    da = rms_norm(da, subln) * (1.0 - lam_init)
    da = da.transpose(0, 2, 1, 3).reshape(B, S, DIFF_WIDTH)
    mixed = jnp.concatenate([sb, da], axis=-1).astype(h.dtype)
    return mixed @ w_out


def hierarchical_moe(h, wg_r, bg_r, we_r, be_r, w_gate, w_up, w_down):
    B, S, D = h.shape
    T = B * S
    M = T * TOP_K
    hf = h.reshape(T, D)
    g_logits = (hf @ wg_r).astype(F32) + bg_r.astype(F32)
    p_group = jax.nn.softmax(g_logits, axis=-1)
    g_sel = jnp.argmax(g_logits, axis=-1)
    p_g = jnp.take_along_axis(p_group, g_sel[:, None], axis=1)
    e_logits = ((hf @ we_r).astype(F32) + be_r.astype(F32)).reshape(T, N_GROUPS, EXPERTS_PER_GROUP)
    e_in = jnp.take_along_axis(e_logits, g_sel[:, None, None], axis=1)[:, 0]
    top_v, top_i = lax.top_k(e_in, TOP_K)
    gate = p_g * jax.nn.softmax(top_v, axis=-1)
    expert = g_sel[:, None] * EXPERTS_PER_GROUP + top_i
    flat_e = expert.reshape(M)
    flat_w = gate.reshape(M)
    order = jnp.argsort(flat_e)
    sorted_e = flat_e[order]
    tok = order // TOP_K
    counts = jnp.bincount(flat_e, length=N_EXPERTS)
    padded = (counts + ROW_BLOCK - 1) // ROW_BLOCK * ROW_BLOCK
    start = jnp.cumsum(counts) - counts
    pstart = jnp.cumsum(padded) - padded
    pend = pstart + padded
    dest = pstart[sorted_e] + (jnp.arange(M) - start[sorted_e])
    n_blocks = -(-M // ROW_BLOCK) + N_EXPERTS
    P = n_blocks * ROW_BLOCK
    xs = jnp.zeros((P, D), hf.dtype).at[dest].set(hf[tok])
    block_start = jnp.arange(n_blocks) * ROW_BLOCK
    block_e = jnp.minimum(jnp.searchsorted(pend, block_start, side='right'), N_EXPERTS - 1)

    def expert_block(args):
        xb, e = args
        a = jax.nn.silu(xb @ w_gate[e]) * (xb @ w_up[e])
        return a @ w_down[e]

    y = lax.map(expert_block, (xs.reshape(n_blocks, ROW_BLOCK, D), block_e)).reshape(P, D)
    y_rows = y[dest] * flat_w[order][:, None].astype(y.dtype)
    out = jax.ops.segment_sum(y_rows, tok, num_segments=T)
    return out.reshape(B, S, D)


def setup_inputs(seed: int = 0) -> dict:
    key = jax.random.key(seed)
    ks = jax.random.split(key, 32)
    n_ab = (DEPTH + 1) // 2
    n_cd = DEPTH // 2

    def nrm(k, shape, scale):
        return jax.random.normal(k, shape, F32) * scale

    def gain(k, shape):
        return 1.0 + 0.02 * jax.random.normal(k, shape, F32)

    x = nrm(ks[0], (BATCH, SEQ, D_MODEL), 1.0)
    offset = jax.random.randint(ks[1], (BATCH, 1), 0, 1024)
    positions = (offset + jnp.arange(SEQ)[None, :]).astype(jnp.int32)
    return {
        "x": x,
        "positions": positions,
        "norm_mix": gain(ks[2], (DEPTH, D_MODEL)),
        "norm_ffn": gain(ks[3], (DEPTH, D_MODEL)),
        "w_in_ab": nrm(ks[4], (n_ab, D_MODEL, AB_IN), D_MODEL ** -0.5),
        "w_out_ab": nrm(ks[5], (n_ab, MIX_WIDTH, D_MODEL), MIX_WIDTH ** -0.5),
        "ret_gnorm": gain(ks[6], (n_ab, RET_HEADS, RET_HEAD_DIM)),
        "hgrn_lb_logits": nrm(ks[7], (DEPTH + 1, HGRN_WIDTH), 0.1),
        "hgrn_onorm": gain(ks[8], (n_ab, HGRN_HEADS, HGRN_DV)),
        "w_in_cd": nrm(ks[9], (n_cd, D_MODEL, CD_IN), D_MODEL ** -0.5),
        "w_out_cd": nrm(ks[10], (n_cd, MIX_WIDTH, D_MODEL), MIX_WIDTH ** -0.5),
        "diff_qnorm": gain(ks[11], (n_cd, DIFF_QK_DIM)),
        "diff_knorm": gain(ks[12], (n_cd, DIFF_QK_DIM)),
        "diff_lam_q1": nrm(ks[13], (n_cd, DIFF_QK_DIM), 0.1),
        "diff_lam_k1": nrm(ks[14], (n_cd, DIFF_QK_DIM), 0.1),
        "diff_lam_q2": nrm(ks[15], (n_cd, DIFF_QK_DIM), 0.1),
        "diff_lam_k2": nrm(ks[16], (n_cd, DIFF_QK_DIM), 0.1),
        "diff_subln": gain(ks[17], (n_cd, DIFF_V_DIM)),
        "router_group_w": nrm(ks[18], (DEPTH, D_MODEL, N_GROUPS), D_MODEL ** -0.5),
        "router_group_b": nrm(ks[19], (DEPTH, N_GROUPS), 0.01),
        "router_expert_w": nrm(ks[20], (DEPTH, D_MODEL, N_EXPERTS), D_MODEL ** -0.5),
        "router_expert_b": nrm(ks[21], (DEPTH, N_EXPERTS), 0.01),
        "w_gate": nrm(ks[22], (DEPTH, N_EXPERTS, D_MODEL, EXPERT_FF), D_MODEL ** -0.5),
        "w_up": nrm(ks[23], (DEPTH, N_EXPERTS, D_MODEL, EXPERT_FF), D_MODEL ** -0.5),
        "w_down": nrm(ks[24], (DEPTH, N_EXPERTS, EXPERT_FF, D_MODEL), EXPERT_FF ** -0.5),
    }


def reference(x, positions, norm_mix, norm_ffn, w_in_ab, w_out_ab, ret_gnorm, hgrn_lb_logits,
              hgrn_onorm, w_in_cd, w_out_cd, diff_qnorm, diff_knorm, diff_lam_q1, diff_lam_k1,
              diff_lam_q2, diff_lam_k2, diff_subln, router_group_w, router_group_b,
              router_expert_w, router_expert_b, w_gate, w_up, w_down):
    cos_r, sin_r = rope_tables(positions, RET_HEAD_DIM)
    cos_d, sin_d = rope_tables(positions, DIFF_QK_DIM)
    lb_table = jnp.cumsum(jax.nn.softmax(hgrn_lb_logits.astype(F32), axis=0), axis=0)
    for l in range(DEPTH):
        h = rms_norm(x, norm_mix[l])
        j = l // 2
        if l % 2 == 0:
            mix = retention_hgrn2_mixer(h, w_in_ab[j], w_out_ab[j], ret_gnorm[j], lb_table[l],
                                        hgrn_onorm[j], cos_r, sin_r)
        else:
            mix = stickbreak_diff_mixer(h, w_in_cd[j], w_out_cd[j], diff_qnorm[j], diff_knorm[j],
                                        diff_lam_q1[j], diff_lam_k1[j], diff_lam_q2[j], diff_lam_k2[j],
                                        diff_subln[j], cos_d, sin_d, l)
        x = x + mix.astype(x.dtype)
        h = rms_norm(x, norm_ffn[l])
        x = x + hierarchical_moe(h, router_group_w[l], router_group_b[l], router_expert_w[l],
                                 router_expert_b[l], w_gate[l], w_up[l], w_down[l]).astype(x.dtype)
    return x
```

```cpp
#include <hip/hip_runtime.h>
#include <cstdio>
#include <cstdint>

constexpr int BATCH = 4, SEQ = 4096, DM = 1024, T_ = BATCH * SEQ;
constexpr int NEXP = 32, EFF = 512;
constexpr float EPS = 1e-6f;
typedef unsigned short bf16_t;
typedef float f32x4 __attribute__((ext_vector_type(4)));
typedef short bf16x8 __attribute__((ext_vector_type(8)));
typedef unsigned u32x4 __attribute__((ext_vector_type(4)));
typedef unsigned u32x2 __attribute__((ext_vector_type(2)));

__device__ __forceinline__ float bf2f(bf16_t v) { return __uint_as_float(((unsigned)v) << 16); }
__device__ __forceinline__ unsigned f2bf(float f) { unsigned u = __float_as_uint(f); return (u + 0x7fffu + ((u >> 16) & 1u)) >> 16; }
__device__ __forceinline__ unsigned pk2(float lo, float hi) { return f2bf(lo) | (f2bf(hi) << 16); }
__device__ __forceinline__ float sigmoidf_(float x) { return 1.0f / (1.0f + __expf(-x)); }
__device__ __forceinline__ float siluf_(float x) { return x / (1.0f + __expf(-x)); }
__device__ __forceinline__ float wave_sum(float v) {
#pragma unroll
    for (int o = 1; o < 64; o <<= 1) v += __shfl_xor(v, o);
    return v;
}

constexpr size_t MiB = 1u << 20;
constexpr size_t WS_CTL = 0, CTL_ZERO_BYTES = 1 * MiB;
constexpr size_t WS_COSR = 1 * MiB, WS_SINR = 5 * MiB, WS_COSD = 9 * MiB, WS_SIND = 11 * MiB, WS_LB0 = 13 * MiB;
constexpr size_t WS_WROUT = 14 * MiB;
constexpr size_t WS_WIN0T = 16 * MiB, WS_WOUT0T = 25 * MiB, WS_WIN1T = 27 * MiB, WS_WOUT1T = 33 * MiB;
constexpr size_t WS_RS = 36 * MiB, WS_HDEC = 52 * MiB, WS_LIST = 53 * MiB, WS_GATEW = 55 * MiB, WS_EXPID = 55 * MiB + 512 * 1024;
constexpr size_t WS_XN = 56 * MiB, WS_HS = 56 * MiB;
constexpr size_t WS_MIX = 88 * MiB;
constexpr size_t WS_ACTS = 120 * MiB;
constexpr size_t WS_MOEW = 280 * MiB;
constexpr size_t WS_END = 472 * MiB;
constexpr size_t A16 = 16 * MiB;
constexpr size_t WS_RQ = WS_ACTS, WS_RK = WS_ACTS + A16, WS_RKT = WS_ACTS + 2 * A16, WS_RVT = WS_ACTS + 3 * A16, WS_RG = WS_ACTS + 4 * A16,
                 WS_HQ = WS_ACTS + 5 * A16, WS_HVT = WS_ACTS + 6 * A16, WS_HG = WS_ACTS + 7 * A16, WS_LOGF = WS_ACTS + 8 * A16;
constexpr size_t WS_SQ = WS_ACTS, WS_SK = WS_ACTS + A16, WS_SVT = WS_ACTS + 2 * A16, WS_DQ = WS_ACTS + 3 * A16, WS_DK = WS_ACTS + 4 * A16, WS_DVT = WS_ACTS + 5 * A16;
constexpr size_t WS_ACT = WS_ACTS, WS_Y = WS_ACTS + 48 * MiB;
constexpr size_t WS_PROJ = WS_MOEW;

__constant__ double INVR[64] = {1.0, 0.8659643233600653, 0.7498942093324559, 0.6493816315762113, 0.5623413251903491, 0.4869675251658631, 0.4216965034285822, 0.3651741272548377, 0.31622776601683794, 0.27384196342643613, 0.23713737056616552, 0.2053525026457146, 0.1778279410038923, 0.1539926526059492, 0.1333521432163324, 0.11547819846894582, 0.1, 0.08659643233600653, 0.07498942093324558, 0.06493816315762113, 0.05623413251903491, 0.04869675251658631, 0.042169650342858224, 0.03651741272548377, 0.03162277660168379, 0.027384196342643614, 0.023713737056616554, 0.02053525026457146, 0.01778279410038923, 0.01539926526059492, 0.01333521432163324, 0.011547819846894581, 0.01, 0.008659643233600653, 0.007498942093324558, 0.006493816315762113, 0.005623413251903491, 0.004869675251658631, 0.004216965034285823, 0.003651741272548377, 0.0031622776601683794, 0.0027384196342643613, 0.0023713737056616554, 0.002053525026457146, 0.0017782794100389228, 0.001539926526059492, 0.0013335214321633241, 0.0011547819846894582, 0.001, 0.0008659643233600654, 0.0007498942093324559, 0.0006493816315762113, 0.0005623413251903491, 0.0004869675251658631, 0.00042169650342858224, 0.0003651741272548377, 0.00031622776601683794, 0.00027384196342643616, 0.00023713737056616554, 0.0002053525026457146, 0.00017782794100389227, 0.0001539926526059492, 0.0001333521432163324, 0.00011547819846894582};
namespace nv {
__device__ __forceinline__ void sincos_d(double a, float& s, float& c) {
    const double k = rint(a * 0.6366197723675814);
    double r = fma(-k, 1.5707963267948966, a); r = fma(-k, 6.123233995736766e-17, r);
    const double r2 = r * r;
    double sp = -1.0 / 1307674368000.0; sp = sp * r2 + 1.0 / 6227020800.0; sp = sp * r2 - 1.0 / 39916800.0; sp = sp * r2 + 1.0 / 362880.0; sp = sp * r2 - 1.0 / 5040.0; sp = sp * r2 + 1.0 / 120.0; sp = sp * r2 - 1.0 / 6.0; sp = sp * r2 * r + r;
    double cp = 1.0 / 20922789888000.0; cp = cp * r2 - 1.0 / 87178291200.0; cp = cp * r2 + 1.0 / 479001600.0; cp = cp * r2 - 1.0 / 3628800.0; cp = cp * r2 + 1.0 / 40320.0; cp = cp * r2 - 1.0 / 720.0; cp = cp * r2 + 1.0 / 24.0; cp = cp * r2 - 0.5; cp = cp * r2 + 1.0;
    const int q = ((int)k) & 3;
    const double ss = (q == 0) ? sp : (q == 1) ? cp : (q == 2) ? -sp : -cp;
    const double cc = (q == 0) ? cp : (q == 1) ? -sp : (q == 2) ? -cp : sp;
    s = (float)ss; c = (float)cc;
}
__global__ void tables(const int* __restrict__ pos, const float* __restrict__ lb_logits, float* cosr, float* sinr, float* cosd, float* sind, float* lb0) {
    const int idx = blockIdx.x * blockDim.x + threadIdx.x;
    if (idx < T_ * 64) { const int t = idx >> 6, i = idx & 63; float s, c; sincos_d((double)pos[t] * INVR[i], s, c); cosr[idx] = c; sinr[idx] = s;
        if ((i & 1) == 0) { cosd[t * 32 + (i >> 1)] = c; sind[t * 32 + (i >> 1)] = s; } }
    if (idx < 512) { const float a = lb_logits[idx], b = lb_logits[512 + idx], c2 = lb_logits[1024 + idx]; const float m = fmaxf(a, fmaxf(b, c2));
        const float ea = expf(a - m), eb = expf(b - m), ec = expf(c2 - m); lb0[idx] = ea / (ea + eb + ec); }
}
__global__ void rowop(const float* base, const float* addf, const bf16_t* Y, float* out, const float* gain, bf16_t* XN) {
    const int row = blockIdx.x * (blockDim.x >> 6) + (threadIdx.x >> 6), lane = threadIdx.x & 63;
    if (row >= T_) return;
    float v[16]; float ss = 0.f;
#pragma unroll
    for (int j = 0; j < 4; ++j) {
        const int c0 = 256 * j + 4 * lane; f32x4 x = *(const f32x4*)(base + (size_t)row * DM + c0);
        if (addf) { const f32x4 a = *(const f32x4*)(addf + (size_t)row * DM + c0); x += a; }
        if (Y) { for (int k = 0; k < 2; ++k) { const u32x2 w = *(const u32x2*)(Y + ((size_t)(2 * row + k)) * DM + c0);
                x[0] += __uint_as_float(w.x << 16); x[1] += __uint_as_float(w.x & 0xffff0000u); x[2] += __uint_as_float(w.y << 16); x[3] += __uint_as_float(w.y & 0xffff0000u); } }
        if (out) *(f32x4*)(out + (size_t)row * DM + c0) = x;
#pragma unroll
        for (int i = 0; i < 4; ++i) { v[4 * j + i] = x[i]; ss += x[i] * x[i]; }
    }
    if (!XN) return;
    const float rstd = rsqrtf(wave_sum(ss) * (1.0f / DM) + EPS);
#pragma unroll
    for (int j = 0; j < 4; ++j) { const int c0 = 256 * j + 4 * lane; const f32x4 g = *(const f32x4*)(gain + c0);
        u32x2 w; w.x = pk2(v[4 * j] * rstd * g[0], v[4 * j + 1] * rstd * g[1]); w.y = pk2(v[4 * j + 2] * rstd * g[2], v[4 * j + 3] * rstd * g[3]);
        *(u32x2*)(XN + (size_t)row * DM + c0) = w; }
}
__global__ void sgemm(const bf16_t* __restrict__ A, int lda, const float* __restrict__ B, int ldb, float* C, int ldc, int K) {
    __shared__ float As[16][65], Bs[16][64];
    const int tid = threadIdx.x, tx = tid & 15, ty = tid >> 4, m0 = blockIdx.y * 64, n0 = blockIdx.x * 64;
    float acc[4][4] = {};
    for (int k0 = 0; k0 < K; k0 += 16) {
        { const int r = tid >> 2, c = (tid & 3) * 4; const u32x2 w = *(const u32x2*)(A + (size_t)(m0 + r) * lda + k0 + c);
          As[c][r] = __uint_as_float(w.x << 16); As[c + 1][r] = __uint_as_float(w.x & 0xffff0000u); As[c + 2][r] = __uint_as_float(w.y << 16); As[c + 3][r] = __uint_as_float(w.y & 0xffff0000u); }
        { const int r = tid >> 4, c = (tid & 15) * 4; *(f32x4*)&Bs[r][c] = *(const f32x4*)(B + (size_t)(k0 + r) * ldb + n0 + c); }
        __syncthreads();
#pragma unroll
        for (int k = 0; k < 16; ++k) { float a[4], b[4];
#pragma unroll
            for (int i = 0; i < 4; ++i) { a[i] = As[k][ty * 4 + i]; b[i] = Bs[k][tx * 4 + i]; }
#pragma unroll
            for (int i = 0; i < 4; ++i)
#pragma unroll
                for (int j = 0; j < 4; ++j) acc[i][j] += a[i] * b[j]; }
        __syncthreads();
    }
#pragma unroll
    for (int i = 0; i < 4; ++i) *(f32x4*)(C + (size_t)(m0 + ty * 4 + i) * ldc + n0 + tx * 4) = (f32x4){acc[i][0], acc[i][1], acc[i][2], acc[i][3]};
}
__global__ void epi_l0(const float* __restrict__ P, int split, const float* cosr, const float* sinr, const float* lb0, unsigned char* ws) {
    const int idx = blockIdx.x * blockDim.x + threadIdx.x; const int t = idx >> 9, j = idx & 511, d = j & 127;
    const float v = P[idx];
    bf16_t* RQ = (bf16_t*)(ws + WS_RQ); bf16_t* RK = (bf16_t*)(ws + WS_RK); bf16_t* RKT = (bf16_t*)(ws + WS_RKT); bf16_t* RVT = (bf16_t*)(ws + WS_RVT); bf16_t* RG = (bf16_t*)(ws + WS_RG);
    bf16_t* HQ = (bf16_t*)(ws + WS_HQ); bf16_t* HVT = (bf16_t*)(ws + WS_HVT); bf16_t* HG = (bf16_t*)(ws + WS_HG); float* LOGF = (float*)(ws + WS_LOGF);
    if (split == 0 || split == 1) {
        const int i = d & 63; const float c = cosr[t * 64 + i], s = sinr[t * 64 + i]; const float other = P[(d < 64) ? idx + 64 : idx - 64];
        float o = (d < 64) ? (v * c - other * s) : (v * c + other * s);
        if (split == 0) { RQ[idx] = (bf16_t)f2bf(o * 0.08838834764831845f); } else { const bf16_t b = (bf16_t)f2bf(o); RK[idx] = b; RKT[(size_t)j * T_ + t] = b; }
    } else if (split == 2) RVT[(size_t)j * T_ + t] = (bf16_t)f2bf(v);
    else if (split == 3) RG[idx] = (bf16_t)f2bf(siluf_(v));
    else if (split == 4) HQ[idx] = (bf16_t)f2bf(siluf_(v) * 0.08838834764831845f);
    else if (split == 5) { const float lb = lb0[j]; LOGF[idx] = logf(lb + (1.0f - lb) * sigmoidf_(v)); }
    else if (split == 6) HVT[(size_t)j * T_ + t] = (bf16_t)f2bf(v);
    else HG[idx] = (bf16_t)f2bf(siluf_(v));
}
template <bool HG> __global__ void __launch_bounds__(512) recur(unsigned char* ws, const float* __restrict__ gain, bf16_t* MIX) {
    __shared__ float sq[128], sk[128], sdec[128], part[4][128], red[8];
    const int bh = blockIdx.x, b = bh >> 2, h = bh & 3, tid = threadIdx.x, e = tid & 127, dq = tid >> 7;
    const bf16_t* Q = (const bf16_t*)(ws + (HG ? WS_HQ : WS_RQ)); const bf16_t* Kk = (const bf16_t*)(ws + WS_RK); const bf16_t* VT = (const bf16_t*)(ws + (HG ? WS_HVT : WS_RVT));
    const bf16_t* G = (const bf16_t*)(ws + (HG ? WS_HG : WS_RG)); const float* LOGF = (const float*)(ws + WS_LOGF);
    const float gamma = 1.0f - exp2f(-5.0f - (float)h);
    float st[32];
#pragma unroll
    for (int i = 0; i < 32; ++i) st[i] = 0.f;
    for (int s = 0; s < SEQ; ++s) {
        const size_t row = (size_t)b * SEQ + s;
        if (tid < 128) { sq[tid] = bf2f(Q[row * 512 + h * 128 + tid]);
            if (HG) { const float f = __expf(LOGF[row * 512 + h * 128 + tid]); sdec[tid] = f; sk[tid] = 1.0f - f; } else { sdec[tid] = gamma; sk[tid] = bf2f(Kk[row * 512 + h * 128 + tid]); } }
        __syncthreads();
        const float v = bf2f(VT[(size_t)(h * 128 + e) * T_ + row]); float po = 0.f;
#pragma unroll
        for (int i = 0; i < 32; ++i) { const int d = dq * 32 + i; st[i] = st[i] * sdec[d] + sk[d] * v; po += sq[d] * st[i]; }
        part[dq][e] = po;
        __syncthreads();
        if (tid < 128) { const float o = part[0][tid] + part[1][tid] + part[2][tid] + part[3][tid]; const float ss = wave_sum(o * o); if ((tid & 63) == 0) red[tid >> 6] = ss; part[0][tid] = o; }
        __syncthreads();
        if (tid < 128) { const float rstd = rsqrtf((red[0] + red[1]) * (1.0f / 128.0f) + EPS);
            MIX[row * DM + (HG ? 512 : 0) + h * 128 + tid] = (bf16_t)f2bf(part[0][tid] * rstd * gain[h * 128 + tid] * bf2f(G[row * 512 + h * 128 + tid])); }
        __syncthreads();
    }
}
__global__ void epi_l1(const float* __restrict__ P, int split, const float* cosd, const float* sind, const float* qg, const float* kg, unsigned char* ws) {
    const int idx = blockIdx.x * blockDim.x + threadIdx.x; const int t = idx >> 9, j = idx & 511;
    const float v = P[idx];
    bf16_t* SQ = (bf16_t*)(ws + WS_SQ); bf16_t* SK = (bf16_t*)(ws + WS_SK); bf16_t* SVT = (bf16_t*)(ws + WS_SVT); bf16_t* DQ = (bf16_t*)(ws + WS_DQ); bf16_t* DK = (bf16_t*)(ws + WS_DK); bf16_t* DVT = (bf16_t*)(ws + WS_DVT);
    if (split == 0) SQ[idx] = (bf16_t)f2bf(v * 0.08838834764831845f);
    else if (split == 1) SK[idx] = (bf16_t)f2bf(v);
    else if (split == 2) SVT[(size_t)j * T_ + t] = (bf16_t)f2bf(v);
    else if (split == 5) DVT[(size_t)j * T_ + t] = (bf16_t)f2bf(v);
    else { const int g0 = idx & ~63, d = j & 63, i = d & 31; float ss = 0.f; for (int u = 0; u < 64; ++u) { const float x = P[g0 + u]; ss += x * x; }
        const float rstd = rsqrtf(ss * (1.0f / 64.0f) + EPS); const float* gn = (split == 3) ? qg : kg;
        const float me = v * rstd * gn[d], ot = P[(d < 32) ? idx + 32 : idx - 32] * rstd * gn[(d < 32) ? d + 32 : d - 32];
        const float c = cosd[t * 32 + i], s = sind[t * 32 + i]; const float o = (d < 32) ? (me * c - ot * s) : (me * c + ot * s);
        if (split == 3) DQ[idx] = (bf16_t)f2bf(o * 0.125f); else DK[idx] = (bf16_t)f2bf(o); }
}
__global__ void sb_attn(unsigned char* ws, bf16_t* MIX) {
    const int w = blockIdx.x * (blockDim.x >> 6) + (threadIdx.x >> 6), lane = threadIdx.x & 63; const int bh = w >> 12, t = w & 4095, b = bh >> 2, h = bh & 3;
    const bf16_t* SQ = (const bf16_t*)(ws + WS_SQ); const bf16_t* SK = (const bf16_t*)(ws + WS_SK); const bf16_t* SVT = (const bf16_t*)(ws + WS_SVT);
    const size_t row = (size_t)b * SEQ + t; const unsigned qw = *(const unsigned*)(SQ + row * 512 + h * 128 + 2 * lane);
    const float q0 = __uint_as_float(qw << 16), q1 = __uint_as_float(qw & 0xffff0000u);
    float o0 = 0.f, o1 = 0.f, R = 0.f;
    const bf16_t* v0p = SVT + (size_t)(h * 128 + 2 * lane) * T_ + (size_t)b * SEQ; const bf16_t* v1p = v0p + T_;
    for (int s = t - 1; s >= 0; --s) {
        const unsigned kw = *(const unsigned*)(SK + ((size_t)b * SEQ + s) * 512 + h * 128 + 2 * lane);
        const float z = wave_sum(q0 * __uint_as_float(kw << 16) + q1 * __uint_as_float(kw & 0xffff0000u));
        const float sp = fmaxf(z, 0.f) + log1pf(__expf(-fabsf(z)));
        const float a = __expf(z - sp - R); R += sp;
        o0 += a * bf2f(v0p[s]); o1 += a * bf2f(v1p[s]);
        if (R > 60.f) break;
    }
    *(unsigned*)(MIX + row * DM + h * 128 + 2 * lane) = pk2(o0, o1);
}
__global__ void diff_attn(unsigned char* ws, const float* lq1, const float* lk1, const float* lq2, const float* lk2, const float* subln, bf16_t* MIX) {
    const int w = blockIdx.x * (blockDim.x >> 6) + (threadIdx.x >> 6), lane = threadIdx.x & 63; const int bh = w >> 12, t = w & 4095, b = bh >> 2, h = bh & 3;
    const bf16_t* DQ = (const bf16_t*)(ws + WS_DQ); const bf16_t* DK = (const bf16_t*)(ws + WS_DK); const bf16_t* DVT = (const bf16_t*)(ws + WS_DVT);
    const float lam_init = 0.8f - 0.6f * expf(-0.3f);
    const float lam = expf(wave_sum(lq1[lane] * lk1[lane])) - expf(wave_sum(lq2[lane] * lk2[lane])) + lam_init;
    const size_t row = (size_t)b * SEQ + t; const float qa = bf2f(DQ[row * 512 + h * 128 + lane]), qb = bf2f(DQ[row * 512 + h * 128 + 64 + lane]);
    float m0 = -1e30f, m1 = -1e30f, l0 = 0.f, l1 = 0.f, a0 = 0.f, a1 = 0.f, b0 = 0.f, b1 = 0.f;
    const bf16_t* v0p = DVT + (size_t)(h * 128 + 2 * lane) * T_ + (size_t)b * SEQ; const bf16_t* v1p = v0p + T_;
    for (int s = 0; s <= t; ++s) {
        const size_t kr = ((size_t)b * SEQ + s) * 512 + h * 128;
        const float z0 = wave_sum(qa * bf2f(DK[kr + lane])), z1 = wave_sum(qb * bf2f(DK[kr + 64 + lane]));
        const float va = bf2f(v0p[s]), vb = bf2f(v1p[s]);
        { const float mn = fmaxf(m0, z0), sc = __expf(m0 - mn), p = __expf(z0 - mn); l0 = l0 * sc + p; a0 = a0 * sc + p * va; a1 = a1 * sc + p * vb; m0 = mn; }
        { const float mn = fmaxf(m1, z1), sc = __expf(m1 - mn), p = __expf(z1 - mn); l1 = l1 * sc + p; b0 = b0 * sc + p * va; b1 = b1 * sc + p * vb; m1 = mn; }
    }
    const float o0 = a0 / l0 - lam * b0 / l1, o1 = a1 / l0 - lam * b1 / l1;
    const float rstd = rsqrtf(wave_sum(o0 * o0 + o1 * o1) * (1.0f / 128.0f) + EPS) * (1.0f - lam_init);
    *(unsigned*)(MIX + row * DM + 512 + h * 128 + 2 * lane) = pk2(o0 * rstd * subln[2 * lane], o1 * rstd * subln[2 * lane + 1]);
}
__global__ void router(const float* __restrict__ X, const float* __restrict__ gain, const float* __restrict__ wg, const float* __restrict__ bg, const float* __restrict__ we, const float* __restrict__ be,
                       int* expid, float* gatew) {
    const int row = blockIdx.x * (blockDim.x >> 6) + (threadIdx.x >> 6), lane = threadIdx.x & 63;
    const float* xr = X + (size_t)row * DM; float ss = 0.f;
    for (int j = 0; j < 16; ++j) { const float x = xr[lane + 64 * j]; ss += x * x; }
    const float rstd = rsqrtf(wave_sum(ss) * (1.0f / DM) + EPS);
    float acc = 0.f;
    if (lane < 36) { for (int d = 0; d < DM; ++d) { const float hv = xr[d] * rstd * gain[d]; acc += hv * (lane < 4 ? wg[d * 4 + lane] : we[d * 32 + lane - 4]); }
        acc += (lane < 4) ? bg[lane] : be[lane - 4]; }
    const float g0 = __shfl(acc, 0), g1 = __shfl(acc, 1), g2 = __shfl(acc, 2), g3 = __shfl(acc, 3);
    int gs = 0; float gm = g0; if (g1 > gm) { gm = g1; gs = 1; } if (g2 > gm) { gm = g2; gs = 2; } if (g3 > gm) { gm = g3; gs = 3; }
    const float pg = 1.0f / (__expf(g0 - gm) + __expf(g1 - gm) + __expf(g2 - gm) + __expf(g3 - gm));
    float v1 = -3.0e38f, v2 = -3.0e38f; int i1 = 0, i2 = 0;
#pragma unroll
    for (int i = 0; i < 8; ++i) { const float ev = __shfl(acc, 4 + gs * 8 + i);
        if (ev > v1) { v2 = v1; i2 = i1; v1 = ev; i1 = i; } else if (ev > v2) { v2 = ev; i2 = i; } }
    const float e2 = __expf(v2 - v1); const float p1 = 1.0f / (1.0f + e2), p2 = e2 / (1.0f + e2);
    if (lane == 0) { expid[2 * row] = gs * 8 + i1; expid[2 * row + 1] = gs * 8 + i2; gatew[2 * row] = pg * p1; gatew[2 * row + 1] = pg * p2; }
}
__global__ void moe_a(const bf16_t* __restrict__ XN, const int* __restrict__ expid, const float* __restrict__ Wg, const float* __restrict__ Wu, bf16_t* ACT) {
    __shared__ float hs[DM];
    const int p = blockIdx.x, t = p >> 1, e = expid[p], tid = threadIdx.x;
    for (int d = tid; d < DM; d += 256) hs[d] = bf2f(XN[(size_t)t * DM + d]);
    __syncthreads();
    const float* g = Wg + (size_t)e * DM * EFF; const float* u = Wu + (size_t)e * DM * EFF;
    float ag0 = 0.f, ag1 = 0.f, au0 = 0.f, au1 = 0.f;
    for (int d = 0; d < DM; ++d) { const float hv = hs[d]; ag0 += hv * g[d * EFF + tid]; ag1 += hv * g[d * EFF + 256 + tid]; au0 += hv * u[d * EFF + tid]; au1 += hv * u[d * EFF + 256 + tid]; }
    ACT[(size_t)p * EFF + tid] = (bf16_t)f2bf(siluf_(ag0) * au0); ACT[(size_t)p * EFF + 256 + tid] = (bf16_t)f2bf(siluf_(ag1) * au1);
}
__global__ void moe_b(const bf16_t* __restrict__ ACT, const int* __restrict__ expid, const float* __restrict__ gatew, const float* __restrict__ Wd, bf16_t* Y) {
    __shared__ float as[EFF];
    const int p = blockIdx.x, e = expid[p], tid = threadIdx.x;
    for (int f = tid; f < EFF; f += 256) as[f] = bf2f(ACT[(size_t)p * EFF + f]);
    __syncthreads();
    const float* w = Wd + (size_t)e * EFF * DM; f32x4 acc = {0.f, 0.f, 0.f, 0.f};
    for (int f = 0; f < EFF; ++f) { const f32x4 wv = *(const f32x4*)(w + (size_t)f * DM + 4 * tid); acc += wv * as[f]; }
    const float gw = gatew[p]; u32x2 o; o.x = pk2(acc[0] * gw, acc[1] * gw); o.y = pk2(acc[2] * gw, acc[3] * gw);
    *(u32x2*)(Y + (size_t)p * DM + 4 * tid) = o;
}
}
struct In {
    const float *x; const int* pos; const float *norm_mix, *norm_ffn, *w_in_ab, *w_out_ab, *ret_gnorm, *lb_logits, *hgrn_onorm, *w_in_cd, *w_out_cd, *qnorm, *knorm, *lq1, *lk1, *lq2, *lk2, *subln,
        *rgw, *rgb, *rew, *reb, *wgate, *wup, *wdown;
};
static void run_naive_layer_tail(const In& I, int l, const float* base, float* out, unsigned char* ws, hipStream_t st, bool last) {
    bf16_t* XN = (bf16_t*)(ws + WS_XN); bf16_t* MIX = (bf16_t*)(ws + WS_MIX); float* PROJ = (float*)(ws + WS_PROJ);
    int* expid = (int*)(ws + WS_EXPID); float* gatew = (float*)(ws + WS_GATEW); bf16_t* ACT = (bf16_t*)(ws + WS_ACT); bf16_t* Y = (bf16_t*)(ws + WS_Y);
    const float* wout = l == 0 ? I.w_out_ab : I.w_out_cd;
    nv::sgemm<<<dim3(DM / 64, T_ / 64), 256, 0, st>>>(MIX, DM, wout, DM, PROJ, DM, DM);
    nv::rowop<<<T_ / 4, 256, 0, st>>>(base, PROJ, nullptr, out, I.norm_ffn + l * DM, XN);
    nv::router<<<T_ / 4, 256, 0, st>>>(out, I.norm_ffn + l * DM, I.rgw + (size_t)l * DM * 4, I.rgb + l * 4, I.rew + (size_t)l * DM * 32, I.reb + l * 32, expid, gatew);
    const size_t WL = (size_t)NEXP * DM * EFF;
    nv::moe_a<<<2 * T_, 256, 0, st>>>(XN, expid, I.wgate + l * WL, I.wup + l * WL, ACT);
    nv::moe_b<<<2 * T_, 256, 0, st>>>(ACT, expid, gatew, I.wdown + l * WL, Y);
    nv::rowop<<<T_ / 4, 256, 0, st>>>(out, nullptr, Y, out, last ? nullptr : I.norm_mix + (l + 1) * DM, last ? nullptr : XN);
}
extern "C" void kernel_launch(void* const* d_in, const int* in_sizes, int n_in, void* d_out, int out_size, void* d_ws, size_t ws_size, hipStream_t stream) {
    if (n_in != 25 || in_sizes[0] != T_ * DM || out_size != T_ * DM || ws_size < WS_END) { fprintf(stderr, "kernel_launch: unexpected shapes (n_in %d, in0 %d, out %d, ws %zu)\n", n_in, n_in > 0 ? in_sizes[0] : -1, out_size, ws_size); return; }
    In I; I.x = (const float*)d_in[0]; I.pos = (const int*)d_in[1]; I.norm_mix = (const float*)d_in[2]; I.norm_ffn = (const float*)d_in[3]; I.w_in_ab = (const float*)d_in[4]; I.w_out_ab = (const float*)d_in[5];
    I.ret_gnorm = (const float*)d_in[6]; I.lb_logits = (const float*)d_in[7]; I.hgrn_onorm = (const float*)d_in[8]; I.w_in_cd = (const float*)d_in[9]; I.w_out_cd = (const float*)d_in[10];
    I.qnorm = (const float*)d_in[11]; I.knorm = (const float*)d_in[12]; I.lq1 = (const float*)d_in[13]; I.lk1 = (const float*)d_in[14]; I.lq2 = (const float*)d_in[15]; I.lk2 = (const float*)d_in[16]; I.subln = (const float*)d_in[17];
    I.rgw = (const float*)d_in[18]; I.rgb = (const float*)d_in[19]; I.rew = (const float*)d_in[20]; I.reb = (const float*)d_in[21]; I.wgate = (const float*)d_in[22]; I.wup = (const float*)d_in[23]; I.wdown = (const float*)d_in[24];
    unsigned char* ws = (unsigned char*)d_ws; float* out = (float*)d_out; hipStream_t st = stream;
    float* cosr = (float*)(ws + WS_COSR); float* sinr = (float*)(ws + WS_SINR); float* cosd = (float*)(ws + WS_COSD); float* sind = (float*)(ws + WS_SIND); float* lb0 = (float*)(ws + WS_LB0);
    bf16_t* XN = (bf16_t*)(ws + WS_XN); bf16_t* MIX = (bf16_t*)(ws + WS_MIX); float* PROJ = (float*)(ws + WS_PROJ);
    nv::tables<<<T_ * 64 / 256, 256, 0, st>>>(I.pos, I.lb_logits, cosr, sinr, cosd, sind, lb0);
    nv::rowop<<<T_ / 4, 256, 0, st>>>(I.x, nullptr, nullptr, nullptr, I.norm_mix, XN);
    for (int sp = 0; sp < 8; ++sp) {
        nv::sgemm<<<dim3(512 / 64, T_ / 64), 256, 0, st>>>(XN, DM, I.w_in_ab + sp * 512, 4096, PROJ, 512, DM);
        nv::epi_l0<<<T_ * 512 / 256, 256, 0, st>>>(PROJ, sp, cosr, sinr, lb0, ws);
    }
    nv::recur<false><<<16, 512, 0, st>>>(ws, I.ret_gnorm, MIX);
    nv::recur<true><<<16, 512, 0, st>>>(ws, I.hgrn_onorm, MIX);
    run_naive_layer_tail(I, 0, I.x, out, ws, st, false);
    for (int sp = 0; sp < 6; ++sp) {
        nv::sgemm<<<dim3(512 / 64, T_ / 64), 256, 0, st>>>(XN, DM, I.w_in_cd + sp * 512, 3072, PROJ, 512, DM);
        nv::epi_l1<<<T_ * 512 / 256, 256, 0, st>>>(PROJ, sp, cosd, sind, I.qnorm, I.knorm, ws);
    }
    nv::sb_attn<<<16 * SEQ / 4, 256, 0, st>>>(ws, MIX);
    nv::diff_attn<<<16 * SEQ / 4, 256, 0, st>>>(ws, I.lq1, I.lk1, I.lq2, I.lk2, I.subln, MIX);
    run_naive_layer_tail(I, 1, out, out, ws, st, true);
}
```

```cpp
#include <hip/hip_runtime.h>
#include <cstdio>
#include <cstdint>

constexpr int BATCH = 4, SEQ = 4096, DM = 1024, T_ = BATCH * SEQ;
constexpr int NEXP = 32, EFF = 512;
constexpr float EPS = 1e-6f;
typedef unsigned short bf16_t;
typedef float f32x4 __attribute__((ext_vector_type(4)));
typedef short bf16x8 __attribute__((ext_vector_type(8)));
typedef unsigned u32x4 __attribute__((ext_vector_type(4)));
typedef unsigned u32x2 __attribute__((ext_vector_type(2)));

__device__ __forceinline__ float bf2f(bf16_t v) { return __uint_as_float(((unsigned)v) << 16); }
__device__ __forceinline__ unsigned f2bf(float f) { unsigned u = __float_as_uint(f); return (u + 0x7fffu + ((u >> 16) & 1u)) >> 16; }
__device__ __forceinline__ unsigned pk2(float lo, float hi) { return f2bf(lo) | (f2bf(hi) << 16); }
__device__ __forceinline__ float sigmoidf_(float x) { return 1.0f / (1.0f + __expf(-x)); }
__device__ __forceinline__ float siluf_(float x) { return x / (1.0f + __expf(-x)); }
__device__ __forceinline__ float wave_sum(float v) {
#pragma unroll
    for (int o = 1; o < 64; o <<= 1) v += __shfl_xor(v, o);
    return v;
}

constexpr size_t MiB = 1u << 20;
constexpr size_t WS_CTL = 0, CTL_ZERO_BYTES = 1 * MiB;
constexpr size_t WS_COSR = 1 * MiB, WS_SINR = 5 * MiB, WS_COSD = 9 * MiB, WS_SIND = 11 * MiB, WS_LB0 = 13 * MiB;
constexpr size_t WS_WROUT = 14 * MiB;
constexpr size_t WS_COSRT = 472 * MiB, WS_SINRT = 476 * MiB;
constexpr size_t WS_WIN0T = 16 * MiB, WS_WOUT0T = 25 * MiB, WS_WIN1T = 27 * MiB, WS_WOUT1T = 33 * MiB;
constexpr size_t WS_RS = 36 * MiB, WS_HDEC = 52 * MiB, WS_LIST = 53 * MiB, WS_GATEW = 55 * MiB, WS_EXPID = 55 * MiB + 512 * 1024;
constexpr size_t WS_XN = 56 * MiB, WS_HS = 56 * MiB;
constexpr size_t WS_MIX = 88 * MiB;
constexpr size_t WS_ACTS = 120 * MiB;
constexpr size_t WS_MOEW = 280 * MiB;
constexpr size_t WS_END = 480 * MiB;
constexpr size_t A16 = 16 * MiB;
constexpr size_t WS_RQ = WS_ACTS, WS_RK = WS_ACTS + A16, WS_RKT = WS_ACTS + 2 * A16, WS_RVT = WS_ACTS + 3 * A16, WS_RG = WS_ACTS + 4 * A16,
                 WS_HQ = WS_ACTS + 5 * A16, WS_HVT = WS_ACTS + 6 * A16, WS_HG = WS_ACTS + 7 * A16, WS_LOGF = WS_ACTS + 8 * A16;
constexpr size_t WS_SQ = WS_ACTS, WS_SK = WS_ACTS + A16, WS_SVT = WS_ACTS + 2 * A16, WS_DQ = WS_ACTS + 3 * A16, WS_DK = WS_ACTS + 4 * A16, WS_DVT = WS_ACTS + 5 * A16;
constexpr size_t WS_ACT = WS_ACTS, WS_Y = WS_ACTS + 48 * MiB;
constexpr size_t WS_PROJ = WS_MOEW;

__constant__ double INVR[64] = {1.0, 0.8659643233600653, 0.7498942093324559, 0.6493816315762113, 0.5623413251903491, 0.4869675251658631, 0.4216965034285822, 0.3651741272548377, 0.31622776601683794, 0.27384196342643613, 0.23713737056616552, 0.2053525026457146, 0.1778279410038923, 0.1539926526059492, 0.1333521432163324, 0.11547819846894582, 0.1, 0.08659643233600653, 0.07498942093324558, 0.06493816315762113, 0.05623413251903491, 0.04869675251658631, 0.042169650342858224, 0.03651741272548377, 0.03162277660168379, 0.027384196342643614, 0.023713737056616554, 0.02053525026457146, 0.01778279410038923, 0.01539926526059492, 0.01333521432163324, 0.011547819846894581, 0.01, 0.008659643233600653, 0.007498942093324558, 0.006493816315762113, 0.005623413251903491, 0.004869675251658631, 0.004216965034285823, 0.003651741272548377, 0.0031622776601683794, 0.0027384196342643613, 0.0023713737056616554, 0.002053525026457146, 0.0017782794100389228, 0.001539926526059492, 0.0013335214321633241, 0.0011547819846894582, 0.001, 0.0008659643233600654, 0.0007498942093324559, 0.0006493816315762113, 0.0005623413251903491, 0.0004869675251658631, 0.00042169650342858224, 0.0003651741272548377, 0.00031622776601683794, 0.00027384196342643616, 0.00023713737056616554, 0.0002053525026457146, 0.00017782794100389227, 0.0001539926526059492, 0.0001333521432163324, 0.00011547819846894582};
namespace nv {
__device__ __forceinline__ void sincos_d(double a, float& s, float& c) {
    const double k = rint(a * 0.6366197723675814);
    double r = fma(-k, 1.5707963267948966, a); r = fma(-k, 6.123233995736766e-17, r);
    const double r2 = r * r;
    double sp = -1.0 / 1307674368000.0; sp = sp * r2 + 1.0 / 6227020800.0; sp = sp * r2 - 1.0 / 39916800.0; sp = sp * r2 + 1.0 / 362880.0; sp = sp * r2 - 1.0 / 5040.0; sp = sp * r2 + 1.0 / 120.0; sp = sp * r2 - 1.0 / 6.0; sp = sp * r2 * r + r;
    double cp = 1.0 / 20922789888000.0; cp = cp * r2 - 1.0 / 87178291200.0; cp = cp * r2 + 1.0 / 479001600.0; cp = cp * r2 - 1.0 / 3628800.0; cp = cp * r2 + 1.0 / 40320.0; cp = cp * r2 - 1.0 / 720.0; cp = cp * r2 + 1.0 / 24.0; cp = cp * r2 - 0.5; cp = cp * r2 + 1.0;
    const int q = ((int)k) & 3;
    const double ss = (q == 0) ? sp : (q == 1) ? cp : (q == 2) ? -sp : -cp;
    const double cc = (q == 0) ? cp : (q == 1) ? -sp : (q == 2) ? -cp : sp;
    s = (float)ss; c = (float)cc;
}
__global__ void tables(const int* __restrict__ pos, const float* __restrict__ lb_logits, float* cosr, float* sinr, float* cosd, float* sind, float* lb0) {
    const int idx = blockIdx.x * blockDim.x + threadIdx.x;
    if (idx < T_ * 64) { const int t = idx >> 6, i = idx & 63; float s, c; sincos_d((double)pos[t] * INVR[i], s, c); cosr[idx] = c; sinr[idx] = s;
        if ((i & 1) == 0) { cosd[t * 32 + (i >> 1)] = c; sind[t * 32 + (i >> 1)] = s; } }
    if (idx < 512) { const float a = lb_logits[idx], b = lb_logits[512 + idx], c2 = lb_logits[1024 + idx]; const float m = fmaxf(a, fmaxf(b, c2));
        const float ea = expf(a - m), eb = expf(b - m), ec = expf(c2 - m); lb0[idx] = ea / (ea + eb + ec); }
}
__global__ void rowop(const float* base, const float* addf, const bf16_t* Y, float* out, const float* gain, bf16_t* XN) {
    const int row = blockIdx.x * (blockDim.x >> 6) + (threadIdx.x >> 6), lane = threadIdx.x & 63;
    if (row >= T_) return;
    float v[16]; float ss = 0.f;
#pragma unroll
    for (int j = 0; j < 4; ++j) {
        const int c0 = 256 * j + 4 * lane; f32x4 x = *(const f32x4*)(base + (size_t)row * DM + c0);
        if (addf) { const f32x4 a = *(const f32x4*)(addf + (size_t)row * DM + c0); x += a; }
        if (Y) { for (int k = 0; k < 2; ++k) { const u32x2 w = *(const u32x2*)(Y + ((size_t)(2 * row + k)) * DM + c0);
                x[0] += __uint_as_float(w.x << 16); x[1] += __uint_as_float(w.x & 0xffff0000u); x[2] += __uint_as_float(w.y << 16); x[3] += __uint_as_float(w.y & 0xffff0000u); } }
        if (out) *(f32x4*)(out + (size_t)row * DM + c0) = x;
#pragma unroll
        for (int i = 0; i < 4; ++i) { v[4 * j + i] = x[i]; ss += x[i] * x[i]; }
    }
    if (!XN) return;
    const float rstd = rsqrtf(wave_sum(ss) * (1.0f / DM) + EPS);
#pragma unroll
    for (int j = 0; j < 4; ++j) { const int c0 = 256 * j + 4 * lane; const f32x4 g = *(const f32x4*)(gain + c0);
        u32x2 w; w.x = pk2(v[4 * j] * rstd * g[0], v[4 * j + 1] * rstd * g[1]); w.y = pk2(v[4 * j + 2] * rstd * g[2], v[4 * j + 3] * rstd * g[3]);
        *(u32x2*)(XN + (size_t)row * DM + c0) = w; }
}
__global__ void sgemm(const bf16_t* __restrict__ A, int lda, const float* __restrict__ B, int ldb, float* C, int ldc, int K) {
    __shared__ float As[16][65], Bs[16][64];
    const int tid = threadIdx.x, tx = tid & 15, ty = tid >> 4, m0 = blockIdx.y * 64, n0 = blockIdx.x * 64;
    float acc[4][4] = {};
    for (int k0 = 0; k0 < K; k0 += 16) {
        { const int r = tid >> 2, c = (tid & 3) * 4; const u32x2 w = *(const u32x2*)(A + (size_t)(m0 + r) * lda + k0 + c);
          As[c][r] = __uint_as_float(w.x << 16); As[c + 1][r] = __uint_as_float(w.x & 0xffff0000u); As[c + 2][r] = __uint_as_float(w.y << 16); As[c + 3][r] = __uint_as_float(w.y & 0xffff0000u); }
        { const int r = tid >> 4, c = (tid & 15) * 4; *(f32x4*)&Bs[r][c] = *(const f32x4*)(B + (size_t)(k0 + r) * ldb + n0 + c); }
        __syncthreads();
#pragma unroll
        for (int k = 0; k < 16; ++k) { float a[4], b[4];
#pragma unroll
            for (int i = 0; i < 4; ++i) { a[i] = As[k][ty * 4 + i]; b[i] = Bs[k][tx * 4 + i]; }
#pragma unroll
            for (int i = 0; i < 4; ++i)
#pragma unroll
                for (int j = 0; j < 4; ++j) acc[i][j] += a[i] * b[j]; }
        __syncthreads();
    }
#pragma unroll
    for (int i = 0; i < 4; ++i) *(f32x4*)(C + (size_t)(m0 + ty * 4 + i) * ldc + n0 + tx * 4) = (f32x4){acc[i][0], acc[i][1], acc[i][2], acc[i][3]};
}
__global__ void epi_l0(const float* __restrict__ P, int split, const float* cosr, const float* sinr, const float* lb0, unsigned char* ws) {
    const int idx = blockIdx.x * blockDim.x + threadIdx.x; const int t = idx >> 9, j = idx & 511, d = j & 127;
    const float v = P[idx];
    bf16_t* RQ = (bf16_t*)(ws + WS_RQ); bf16_t* RK = (bf16_t*)(ws + WS_RK); bf16_t* RKT = (bf16_t*)(ws + WS_RKT); bf16_t* RVT = (bf16_t*)(ws + WS_RVT); bf16_t* RG = (bf16_t*)(ws + WS_RG);
    bf16_t* HQ = (bf16_t*)(ws + WS_HQ); bf16_t* HVT = (bf16_t*)(ws + WS_HVT); bf16_t* HG = (bf16_t*)(ws + WS_HG); float* LOGF = (float*)(ws + WS_LOGF);
    if (split == 0 || split == 1) {
        const int i = d & 63; const float c = cosr[t * 64 + i], s = sinr[t * 64 + i]; const float other = P[(d < 64) ? idx + 64 : idx - 64];
        float o = (d < 64) ? (v * c - other * s) : (v * c + other * s);
        if (split == 0) { RQ[idx] = (bf16_t)f2bf(o * 0.08838834764831845f); } else { const bf16_t b = (bf16_t)f2bf(o); RK[idx] = b; RKT[(size_t)j * T_ + t] = b; }
    } else if (split == 2) RVT[(size_t)j * T_ + t] = (bf16_t)f2bf(v);
    else if (split == 3) RG[idx] = (bf16_t)f2bf(siluf_(v));
    else if (split == 4) HQ[idx] = (bf16_t)f2bf(siluf_(v) * 0.08838834764831845f);
    else if (split == 5) { const float lb = lb0[j]; LOGF[idx] = logf(lb + (1.0f - lb) * sigmoidf_(v)); }
    else if (split == 6) HVT[(size_t)j * T_ + t] = (bf16_t)f2bf(v);
    else HG[idx] = (bf16_t)f2bf(siluf_(v));
}
template <bool HG> __global__ void __launch_bounds__(512) recur(unsigned char* ws, const float* __restrict__ gain, bf16_t* MIX) {
    __shared__ float sq[128], sk[128], sdec[128], part[4][128], red[8];
    const int bh = blockIdx.x, b = bh >> 2, h = bh & 3, tid = threadIdx.x, e = tid & 127, dq = tid >> 7;
    const bf16_t* Q = (const bf16_t*)(ws + (HG ? WS_HQ : WS_RQ)); const bf16_t* Kk = (const bf16_t*)(ws + WS_RK); const bf16_t* VT = (const bf16_t*)(ws + (HG ? WS_HVT : WS_RVT));
    const bf16_t* G = (const bf16_t*)(ws + (HG ? WS_HG : WS_RG)); const float* LOGF = (const float*)(ws + WS_LOGF);
    const float gamma = 1.0f - exp2f(-5.0f - (float)h);
    float st[32];
#pragma unroll
    for (int i = 0; i < 32; ++i) st[i] = 0.f;
    for (int s = 0; s < SEQ; ++s) {
        const size_t row = (size_t)b * SEQ + s;
        if (tid < 128) { sq[tid] = bf2f(Q[row * 512 + h * 128 + tid]);
            if (HG) { const float f = __expf(LOGF[row * 512 + h * 128 + tid]); sdec[tid] = f; sk[tid] = 1.0f - f; } else { sdec[tid] = gamma; sk[tid] = bf2f(Kk[row * 512 + h * 128 + tid]); } }
        __syncthreads();
        const float v = bf2f(VT[(size_t)(h * 128 + e) * T_ + row]); float po = 0.f;
#pragma unroll
        for (int i = 0; i < 32; ++i) { const int d = dq * 32 + i; st[i] = st[i] * sdec[d] + sk[d] * v; po += sq[d] * st[i]; }
        part[dq][e] = po;
        __syncthreads();
        if (tid < 128) { const float o = part[0][tid] + part[1][tid] + part[2][tid] + part[3][tid]; const float ss = wave_sum(o * o); if ((tid & 63) == 0) red[tid >> 6] = ss; part[0][tid] = o; }
        __syncthreads();
        if (tid < 128) { const float rstd = rsqrtf((red[0] + red[1]) * (1.0f / 128.0f) + EPS);
            MIX[row * DM + (HG ? 512 : 0) + h * 128 + tid] = (bf16_t)f2bf(part[0][tid] * rstd * gain[h * 128 + tid] * bf2f(G[row * 512 + h * 128 + tid])); }
        __syncthreads();
    }
}
__global__ void epi_l1(const float* __restrict__ P, int split, const float* cosd, const float* sind, const float* qg, const float* kg, unsigned char* ws) {
    const int idx = blockIdx.x * blockDim.x + threadIdx.x; const int t = idx >> 9, j = idx & 511;
    const float v = P[idx];
    bf16_t* SQ = (bf16_t*)(ws + WS_SQ); bf16_t* SK = (bf16_t*)(ws + WS_SK); bf16_t* SVT = (bf16_t*)(ws + WS_SVT); bf16_t* DQ = (bf16_t*)(ws + WS_DQ); bf16_t* DK = (bf16_t*)(ws + WS_DK); bf16_t* DVT = (bf16_t*)(ws + WS_DVT);
    if (split == 0) SQ[idx] = (bf16_t)f2bf(v * 0.08838834764831845f);
    else if (split == 1) SK[idx] = (bf16_t)f2bf(v);
    else if (split == 2) SVT[(size_t)j * T_ + t] = (bf16_t)f2bf(v);
    else if (split == 5) DVT[(size_t)j * T_ + t] = (bf16_t)f2bf(v);
    else { const int g0 = idx & ~63, d = j & 63, i = d & 31; float ss = 0.f; for (int u = 0; u < 64; ++u) { const float x = P[g0 + u]; ss += x * x; }
        const float rstd = rsqrtf(ss * (1.0f / 64.0f) + EPS); const float* gn = (split == 3) ? qg : kg;
        const float me = v * rstd * gn[d], ot = P[(d < 32) ? idx + 32 : idx - 32] * rstd * gn[(d < 32) ? d + 32 : d - 32];
        const float c = cosd[t * 32 + i], s = sind[t * 32 + i]; const float o = (d < 32) ? (me * c - ot * s) : (me * c + ot * s);
        if (split == 3) DQ[idx] = (bf16_t)f2bf(o * 0.125f); else DK[idx] = (bf16_t)f2bf(o); }
}
__global__ void sb_attn(unsigned char* ws, bf16_t* MIX) {
    const int w = blockIdx.x * (blockDim.x >> 6) + (threadIdx.x >> 6), lane = threadIdx.x & 63; const int bh = w >> 12, t = w & 4095, b = bh >> 2, h = bh & 3;
    const bf16_t* SQ = (const bf16_t*)(ws + WS_SQ); const bf16_t* SK = (const bf16_t*)(ws + WS_SK); const bf16_t* SVT = (const bf16_t*)(ws + WS_SVT);
    const size_t row = (size_t)b * SEQ + t; const unsigned qw = *(const unsigned*)(SQ + row * 512 + h * 128 + 2 * lane);
    const float q0 = __uint_as_float(qw << 16), q1 = __uint_as_float(qw & 0xffff0000u);
    float o0 = 0.f, o1 = 0.f, R = 0.f;
    const bf16_t* v0p = SVT + (size_t)(h * 128 + 2 * lane) * T_ + (size_t)b * SEQ; const bf16_t* v1p = v0p + T_;
    for (int s = t - 1; s >= 0; --s) {
        const unsigned kw = *(const unsigned*)(SK + ((size_t)b * SEQ + s) * 512 + h * 128 + 2 * lane);
        const float z = wave_sum(q0 * __uint_as_float(kw << 16) + q1 * __uint_as_float(kw & 0xffff0000u));
        const float sp = fmaxf(z, 0.f) + log1pf(__expf(-fabsf(z)));
        const float a = __expf(z - sp - R); R += sp;
        o0 += a * bf2f(v0p[s]); o1 += a * bf2f(v1p[s]);
        if (R > 60.f) break;
    }
    *(unsigned*)(MIX + row * DM + h * 128 + 2 * lane) = pk2(o0, o1);
}
__global__ void diff_attn(unsigned char* ws, const float* lq1, const float* lk1, const float* lq2, const float* lk2, const float* subln, bf16_t* MIX) {
    const int w = blockIdx.x * (blockDim.x >> 6) + (threadIdx.x >> 6), lane = threadIdx.x & 63; const int bh = w >> 12, t = w & 4095, b = bh >> 2, h = bh & 3;
    const bf16_t* DQ = (const bf16_t*)(ws + WS_DQ); const bf16_t* DK = (const bf16_t*)(ws + WS_DK); const bf16_t* DVT = (const bf16_t*)(ws + WS_DVT);
    const float lam_init = 0.8f - 0.6f * expf(-0.3f);
    const float lam = expf(wave_sum(lq1[lane] * lk1[lane])) - expf(wave_sum(lq2[lane] * lk2[lane])) + lam_init;
    const size_t row = (size_t)b * SEQ + t; const float qa = bf2f(DQ[row * 512 + h * 128 + lane]), qb = bf2f(DQ[row * 512 + h * 128 + 64 + lane]);
    float m0 = -1e30f, m1 = -1e30f, l0 = 0.f, l1 = 0.f, a0 = 0.f, a1 = 0.f, b0 = 0.f, b1 = 0.f;
    const bf16_t* v0p = DVT + (size_t)(h * 128 + 2 * lane) * T_ + (size_t)b * SEQ; const bf16_t* v1p = v0p + T_;
    for (int s = 0; s <= t; ++s) {
        const size_t kr = ((size_t)b * SEQ + s) * 512 + h * 128;
        const float z0 = wave_sum(qa * bf2f(DK[kr + lane])), z1 = wave_sum(qb * bf2f(DK[kr + 64 + lane]));
        const float va = bf2f(v0p[s]), vb = bf2f(v1p[s]);
        { const float mn = fmaxf(m0, z0), sc = __expf(m0 - mn), p = __expf(z0 - mn); l0 = l0 * sc + p; a0 = a0 * sc + p * va; a1 = a1 * sc + p * vb; m0 = mn; }
        { const float mn = fmaxf(m1, z1), sc = __expf(m1 - mn), p = __expf(z1 - mn); l1 = l1 * sc + p; b0 = b0 * sc + p * va; b1 = b1 * sc + p * vb; m1 = mn; }
    }
    const float o0 = a0 / l0 - lam * b0 / l1, o1 = a1 / l0 - lam * b1 / l1;
    const float rstd = rsqrtf(wave_sum(o0 * o0 + o1 * o1) * (1.0f / 128.0f) + EPS) * (1.0f - lam_init);
    *(unsigned*)(MIX + row * DM + 512 + h * 128 + 2 * lane) = pk2(o0 * rstd * subln[2 * lane], o1 * rstd * subln[2 * lane + 1]);
}
__global__ void router(const float* __restrict__ X, const float* __restrict__ gain, const float* __restrict__ wg, const float* __restrict__ bg, const float* __restrict__ we, const float* __restrict__ be,
                       int* expid, float* gatew) {
    const int row = blockIdx.x * (blockDim.x >> 6) + (threadIdx.x >> 6), lane = threadIdx.x & 63;
    const float* xr = X + (size_t)row * DM; float ss = 0.f;
    for (int j = 0; j < 16; ++j) { const float x = xr[lane + 64 * j]; ss += x * x; }
    const float rstd = rsqrtf(wave_sum(ss) * (1.0f / DM) + EPS);
    float acc = 0.f;
    if (lane < 36) { for (int d = 0; d < DM; ++d) { const float hv = xr[d] * rstd * gain[d]; acc += hv * (lane < 4 ? wg[d * 4 + lane] : we[d * 32 + lane - 4]); }
        acc += (lane < 4) ? bg[lane] : be[lane - 4]; }
    const float g0 = __shfl(acc, 0), g1 = __shfl(acc, 1), g2 = __shfl(acc, 2), g3 = __shfl(acc, 3);
    int gs = 0; float gm = g0; if (g1 > gm) { gm = g1; gs = 1; } if (g2 > gm) { gm = g2; gs = 2; } if (g3 > gm) { gm = g3; gs = 3; }
    const float pg = 1.0f / (__expf(g0 - gm) + __expf(g1 - gm) + __expf(g2 - gm) + __expf(g3 - gm));
    float v1 = -3.0e38f, v2 = -3.0e38f; int i1 = 0, i2 = 0;
#pragma unroll
    for (int i = 0; i < 8; ++i) { const float ev = __shfl(acc, 4 + gs * 8 + i);
        if (ev > v1) { v2 = v1; i2 = i1; v1 = ev; i1 = i; } else if (ev > v2) { v2 = ev; i2 = i; } }
    const float e2 = __expf(v2 - v1); const float p1 = 1.0f / (1.0f + e2), p2 = e2 / (1.0f + e2);
    if (lane == 0) { expid[2 * row] = gs * 8 + i1; expid[2 * row + 1] = gs * 8 + i2; gatew[2 * row] = pg * p1; gatew[2 * row + 1] = pg * p2; }
}
__global__ void moe_a(const bf16_t* __restrict__ XN, const int* __restrict__ expid, const float* __restrict__ Wg, const float* __restrict__ Wu, bf16_t* ACT) {
    __shared__ float hs[DM];
    const int p = blockIdx.x, t = p >> 1, e = expid[p], tid = threadIdx.x;
    for (int d = tid; d < DM; d += 256) hs[d] = bf2f(XN[(size_t)t * DM + d]);
    __syncthreads();
    const float* g = Wg + (size_t)e * DM * EFF; const float* u = Wu + (size_t)e * DM * EFF;
    float ag0 = 0.f, ag1 = 0.f, au0 = 0.f, au1 = 0.f;
    for (int d = 0; d < DM; ++d) { const float hv = hs[d]; ag0 += hv * g[d * EFF + tid]; ag1 += hv * g[d * EFF + 256 + tid]; au0 += hv * u[d * EFF + tid]; au1 += hv * u[d * EFF + 256 + tid]; }
    ACT[(size_t)p * EFF + tid] = (bf16_t)f2bf(siluf_(ag0) * au0); ACT[(size_t)p * EFF + 256 + tid] = (bf16_t)f2bf(siluf_(ag1) * au1);
}
__global__ void moe_b(const bf16_t* __restrict__ ACT, const int* __restrict__ expid, const float* __restrict__ gatew, const float* __restrict__ Wd, bf16_t* Y) {
    __shared__ float as[EFF];
    const int p = blockIdx.x, e = expid[p], tid = threadIdx.x;
    for (int f = tid; f < EFF; f += 256) as[f] = bf2f(ACT[(size_t)p * EFF + f]);
    __syncthreads();
    const float* w = Wd + (size_t)e * EFF * DM; f32x4 acc = {0.f, 0.f, 0.f, 0.f};
    for (int f = 0; f < EFF; ++f) { const f32x4 wv = *(const f32x4*)(w + (size_t)f * DM + 4 * tid); acc += wv * as[f]; }
    const float gw = gatew[p]; u32x2 o; o.x = pk2(acc[0] * gw, acc[1] * gw); o.y = pk2(acc[2] * gw, acc[3] * gw);
    *(u32x2*)(Y + (size_t)p * DM + 4 * tid) = o;
}
}
namespace pg8 {
#define PG8_LAS __attribute__((address_space(3)))
constexpr int BM = 256, BK = 64, HALF = 128, HTB = HALF * BK * 2  , STAGE_BYTES = 8 * HTB, NXCD = 8, WGM = 8;
__host__ __device__ __forceinline__ int lds_byte(int r, int c) { const int st = (r >> 4) * 2 + (c >> 5), rr = r & 15, cc = c & 31, ob = rr * 64 + cc * 2; return st * 1024 + (ob ^ (((ob >> 9) & 1) << 5)); }
__host__ __device__ __forceinline__ void stage_rc(int b, int& R, int& C) { const int st = b / 1024, sb = b % 1024, swz = sb ^ (((sb >> 9) & 1) << 5); R = (st >> 1) * 16 + swz / 64; C = (st & 1) * 32 + (swz % 64) / 2; }
__host__ __device__ __forceinline__ int perm32(int rho) { const int n = rho >> 4, i = rho & 15; return 8 * (i >> 2) + 4 * n + (i & 3); }
__device__ __forceinline__ unsigned cvt_pk_bf16(float lo, float hi) { unsigned r; asm volatile("v_cvt_pk_bf16_f32 %0, %1, %2" : "=v"(r) : "v"(lo), "v"(hi)); return r; }

struct Unit { int pm, pn; };
struct StaticOrder {
    int nM, nN, nwg, G, c, K;
    __device__ void init(int M, int N, int K_, int G_, int c_) { nM = M / BM; nN = N / BM; nwg = nM * nN; G = G_; c = c_; K = K_; }
    __device__ bool next(int i, Unit& u) const {
        const long L = (long)i * G + c; if (L >= nwg) return false;
        int wgid = (int)L; { const int q = nwg / NXCD, r = nwg % NXCD, xcd = wgid % NXCD, off = wgid / NXCD; wgid = (xcd < r ? xcd * (q + 1) : r * (q + 1) + (xcd - r) * q) + off; }
        const int nig = WGM * nN, gid = wgid / nig, fm = gid * WGM, gsz = (nM - fm) < WGM ? (nM - fm) : WGM;
        u.pm = fm + ((wgid % nig) % gsz); u.pn = (wgid % nig) / gsz; return true;
    }
    __device__ __forceinline__ unsigned arow(const Unit& u, int r) const { return (unsigned)(u.pm * BM + r); }
    __device__ __forceinline__ size_t boff(const Unit& u) const { return (size_t)u.pn * BM * K * 2; }
};

template <class Epi, class Sched>
__device__ __forceinline__ void gemm_phase(PG8_LAS unsigned char* lds, const bf16_t* Aptr, const bf16_t* Btptr, const int K, const Sched& S, const Epi& E) {
    const int tid = threadIdx.x, wid = __builtin_amdgcn_readfirstlane(tid >> 6), lane = tid & 63, wr = wid >> 2, wc = wid & 3, fr = lane & 15, fq = lane >> 4;
    const int nt = K / BK;
    int RA[2], CA[2]; unsigned voffB[2];
#pragma unroll
    for (int i = 0; i < 2; ++i) { int R, C; stage_rc(tid * 16 + i * 8192, R, C); const int Rb = Epi::PERM ? ((R & ~31) + perm32(R & 31)) : R; RA[i] = R; CA[i] = C; voffB[i] = (unsigned)(Rb * K + C) * 2u; }
    const size_t kstep = (size_t)(BK * 2);
    const size_t hstep = (size_t)HALF * K * 2;
    const unsigned ldsw = (unsigned)wid * 1024u;
    const int aoff = lds_byte(wr * 64 + fr, fq * 8), boff = lds_byte(wc * 32 + fr, fq * 8);
#define PG8_SA(b, h) (((b) * 2 + (h)) * HTB)
#define PG8_SB(b, h) ((4 + (b) * 2 + (h)) * HTB)
#define PG8_STAGE(bufoff, gbase, voff) do { _Pragma("unroll") for (int _i = 0; _i < 2; ++_i) \
        __builtin_amdgcn_global_load_lds((const unsigned*)((const char*)(gbase) + (voff)[_i]), (PG8_LAS unsigned*)(lds + (bufoff) + ldsw + _i * 8192), 16, 0, 0); } while (0)
#define PG8_LDA(dst, b, h) do { _Pragma("unroll") for (int m = 0; m < 4; ++m) _Pragma("unroll") for (int k = 0; k < 2; ++k) dst[m][k] = *(const PG8_LAS bf16x8*)(lds + PG8_SA(b, h) + aoff + m * 2048 + k * 1024); } while (0)
#define PG8_LDB(dst, b, h) do { _Pragma("unroll") for (int n = 0; n < 2; ++n) _Pragma("unroll") for (int k = 0; k < 2; ++k) dst[n][k] = *(const PG8_LAS bf16x8*)(lds + PG8_SB(b, h) + boff + n * 2048 + k * 1024); } while (0)
#define PG8_MMA(ai, bj, At, Bt) do { __builtin_amdgcn_s_setprio(1); _Pragma("unroll") for (int m = 0; m < 4; ++m) _Pragma("unroll") for (int n = 0; n < 2; ++n) _Pragma("unroll") for (int k = 0; k < 2; ++k) \
        acc[ai][bj][m][n] = __builtin_amdgcn_mfma_f32_16x16x32_bf16(Bt[n][k], At[m][k], acc[ai][bj][m][n], 0, 0, 0); __builtin_amdgcn_s_setprio(0); } while (0)
#define PG8_WAIT_V(n) asm volatile("s_waitcnt vmcnt(" #n ")" ::: "memory")
#define PG8_WAIT_L(n) asm volatile("s_waitcnt lgkmcnt(" #n ")" ::: "memory")
#define PG8_BAR __builtin_amdgcn_s_barrier()
#define PG8_SCHED __builtin_amdgcn_sched_barrier(0)
#define PG8_AOFF(dst, u) do { _Pragma("unroll") for (int _h = 0; _h < 2; ++_h) _Pragma("unroll") for (int _i = 0; _i < 2; ++_i) dst[_h][_i] = (S.arow(u, _h * HALF + RA[_i]) * (unsigned)K + (unsigned)CA[_i]) * 2u; } while (0)
    Unit cur, nxt; int ui = 0;
    if (!S.next(0, cur)) return;
    f32x4 acc[2][2][4][2];
#pragma unroll
    for (int a = 0; a < 2; ++a)
#pragma unroll
        for (int b = 0; b < 2; ++b)
#pragma unroll
            for (int m = 0; m < 4; ++m)
#pragma unroll
                for (int n = 0; n < 2; ++n) acc[a][b][m][n] = (f32x4){0.f, 0.f, 0.f, 0.f};
    bf16x8 At[4][2], B0[2][2], B1[2][2];
    unsigned vA[2][2], vAn[2][2];
    PG8_AOFF(vA, cur);
    const char* gA = (const char*)Aptr;
    const char* cB = (const char*)Btptr + S.boff(cur);
    PG8_STAGE(PG8_SB(0, 0), cB, voffB); PG8_STAGE(PG8_SB(0, 1), cB + hstep, voffB); PG8_STAGE(PG8_SA(0, 0), gA, vA[0]); PG8_STAGE(PG8_SA(0, 1), gA, vA[1]);
    if (wr == 1) PG8_BAR;
    PG8_WAIT_V(2); PG8_BAR;
    PG8_STAGE(PG8_SB(1, 0), cB + kstep, voffB); PG8_STAGE(PG8_SA(1, 0), gA + kstep, vA[0]); PG8_STAGE(PG8_SB(1, 1), cB + hstep + kstep, voffB);
    PG8_WAIT_V(6); PG8_BAR;
    for (;;) {
        const bool has_next = S.next(ui + 1, nxt);
        if (has_next) { PG8_AOFF(vAn, nxt); } else {
#pragma unroll
            for (int h = 0; h < 2; ++h)
#pragma unroll
                for (int i = 0; i < 2; ++i) vAn[h][i] = vA[h][i]; }
        const char* nB = has_next ? (const char*)Btptr + S.boff(nxt) : cB;
        for (int t = 0; t < nt; t += 2) {
            const bool last = (t == nt - 2);
            const char* a1 = gA + (size_t)(t + 1) * kstep;
            const char* a2 = last ? gA : gA + (size_t)(t + 2) * kstep; const char* b2 = last ? nB : cB + (size_t)(t + 2) * kstep;
            const char* a3 = a2 + kstep; const char* b3 = b2 + kstep;
            unsigned v2[2][2];
#pragma unroll
            for (int h = 0; h < 2; ++h)
#pragma unroll
                for (int i = 0; i < 2; ++i) v2[h][i] = last ? vAn[h][i] : vA[h][i];
            PG8_LDB(B0, 0, 0); PG8_LDB(B1, 0, 1); PG8_SCHED; PG8_LDA(At, 0, 0); PG8_STAGE(PG8_SA(1, 1), a1, vA[1]);
            PG8_WAIT_V(8); PG8_WAIT_L(0); PG8_BAR; PG8_MMA(0, 0, At, B0); PG8_MMA(0, 1, At, B1); PG8_BAR; PG8_SCHED;
            PG8_LDA(At, 0, 1); PG8_STAGE(PG8_SB(0, 0), b2, voffB); PG8_STAGE(PG8_SB(0, 1), b2 + hstep, voffB); PG8_STAGE(PG8_SA(0, 0), a2, v2[0]);
            PG8_WAIT_V(8); PG8_WAIT_L(0); PG8_BAR; PG8_MMA(1, 0, At, B0); PG8_MMA(1, 1, At, B1); PG8_BAR; PG8_SCHED;
            PG8_LDB(B0, 1, 0); PG8_LDB(B1, 1, 1); PG8_SCHED; PG8_LDA(At, 1, 0); PG8_STAGE(PG8_SA(0, 1), a2, v2[1]);
            PG8_WAIT_V(8); PG8_WAIT_L(0); PG8_BAR; PG8_MMA(0, 0, At, B0); PG8_MMA(0, 1, At, B1); PG8_BAR; PG8_SCHED;
            PG8_LDA(At, 1, 1); PG8_STAGE(PG8_SB(1, 0), b3, voffB); PG8_STAGE(PG8_SB(1, 1), b3 + hstep, voffB); PG8_STAGE(PG8_SA(1, 0), a3, v2[0]);
            PG8_WAIT_V(8); PG8_WAIT_L(0); PG8_BAR; PG8_MMA(1, 0, At, B0); PG8_MMA(1, 1, At, B1); PG8_BAR; PG8_SCHED;
        }
        if (wr == 0) PG8_BAR;
        E(acc, cur, wr, wc, fr, fq);
        if (!has_next) break;
#pragma unroll
        for (int a = 0; a < 2; ++a)
#pragma unroll
            for (int b = 0; b < 2; ++b)
#pragma unroll
                for (int m = 0; m < 4; ++m)
#pragma unroll
                    for (int n = 0; n < 2; ++n) acc[a][b][m][n] = (f32x4){0.f, 0.f, 0.f, 0.f};
        cur = nxt; cB = nB; ++ui;
#pragma unroll
        for (int h = 0; h < 2; ++h)
#pragma unroll
            for (int i = 0; i < 2; ++i) vA[h][i] = vAn[h][i];
        if (wr == 1) PG8_BAR;
    }
    PG8_WAIT_V(0);
    PG8_BAR;
#undef PG8_SA
#undef PG8_SB
#undef PG8_STAGE
#undef PG8_LDA
#undef PG8_LDB
#undef PG8_MMA
#undef PG8_WAIT_V
#undef PG8_WAIT_L
#undef PG8_BAR
#undef PG8_SCHED
#undef PG8_AOFF
}
}
namespace epi {
using pg8::Unit; using pg8::cvt_pk_bf16;
typedef const f32x4 (&Acc)[2][2][4][2];
__device__ __forceinline__ u32x4 pack8(const f32x4& a, const f32x4& b) { u32x4 w; w.x = cvt_pk_bf16(a[0], a[1]); w.y = cvt_pk_bf16(a[2], a[3]); w.z = cvt_pk_bf16(b[0], b[1]); w.w = cvt_pk_bf16(b[2], b[3]); return w; }
__device__ __forceinline__ f32x4 silu4(const f32x4& v) { f32x4 o; for (int i = 0; i < 4; ++i) o[i] = v[i] / (1.0f + __expf(-v[i])); return o; }

struct L0N {
    static constexpr bool PERM = true;
    unsigned char* ws; const float* cosr; const float* sinr; const float* lb0;
    __device__ __forceinline__ void operator()(Acc acc, const Unit& u, int wr, int wc, int fr, int fq) const {
        const int kind = u.pn >> 1, colt = (u.pn & 1) * 256;
        if (kind < 2) {
            bf16_t* O = (bf16_t*)(ws + (kind == 0 ? WS_RQ : WS_RK)); const float sc = kind == 0 ? 0.08838834764831845f : 1.0f;
            const int hh = wc >> 1, i0 = 32 * (wc & 1) + 8 * fq;
#pragma unroll
            for (int ai = 0; ai < 2; ++ai)
#pragma unroll
                for (int m = 0; m < 4; ++m) { const int row = u.pm * 256 + ai * 128 + wr * 64 + m * 16 + fr;
                    f32x4 lo[2], hi[2];
#pragma unroll
                    for (int n = 0; n < 2; ++n) { const f32x4 c = *(const f32x4*)(cosr + (size_t)row * 64 + i0 + 4 * n), s = *(const f32x4*)(sinr + (size_t)row * 64 + i0 + 4 * n);
                        const f32x4 x1 = acc[ai][0][m][n], x2 = acc[ai][1][m][n]; lo[n] = (x1 * c - x2 * s) * sc; hi[n] = (x2 * c + x1 * s) * sc; }
                    bf16_t* rp = O + (size_t)row * 512 + colt + hh * 128 + i0;
                    *(u32x4*)rp = pack8(lo[0], lo[1]); *(u32x4*)(rp + 64) = pack8(hi[0], hi[1]); }
        } else if (kind == 4) {
            float* O = (float*)(ws + WS_LOGF);
#pragma unroll
            for (int bj = 0; bj < 2; ++bj) { const int col = colt + bj * 128 + wc * 32 + 8 * fq; f32x4 lb[2]; lb[0] = *(const f32x4*)(lb0 + col); lb[1] = *(const f32x4*)(lb0 + col + 4);
#pragma unroll
                for (int ai = 0; ai < 2; ++ai)
#pragma unroll
                    for (int m = 0; m < 4; ++m) { const int row = u.pm * 256 + ai * 128 + wr * 64 + m * 16 + fr;
#pragma unroll
                        for (int n = 0; n < 2; ++n) { f32x4 o; const f32x4 v = acc[ai][bj][m][n];
#pragma unroll
                            for (int i = 0; i < 4; ++i) o[i] = __logf(lb[n][i] + (1.0f - lb[n][i]) / (1.0f + __expf(-v[i])));
                            *(f32x4*)(O + (size_t)row * 512 + col + 4 * n) = o; } } }
        } else {
            bf16_t* O = (bf16_t*)(ws + (kind == 2 ? WS_RG : kind == 3 ? WS_HQ : WS_HG)); const float sc = kind == 3 ? 0.08838834764831845f : 1.0f;
#pragma unroll
            for (int ai = 0; ai < 2; ++ai)
#pragma unroll
                for (int m = 0; m < 4; ++m) { const int row = u.pm * 256 + ai * 128 + wr * 64 + m * 16 + fr;
#pragma unroll
                    for (int bj = 0; bj < 2; ++bj) { const int col = colt + bj * 128 + wc * 32 + 8 * fq;
                        *(u32x4*)(O + (size_t)row * 512 + col) = pack8(silu4(acc[ai][bj][m][0]) * sc, silu4(acc[ai][bj][m][1]) * sc); } }
        }
    }
};
struct TR {
    static constexpr bool PERM = true;
    unsigned char* ws; const float* cosT; const float* sinT; int layer;
    __device__ __forceinline__ void operator()(Acc acc, const Unit& u, int wr, int wc, int fr, int fq) const {
        const int kind = u.pm >> 1, rowt = (u.pm & 1) * 256;
        if (layer == 0 && kind == 0) {
            bf16_t* O = (bf16_t*)(ws + WS_RKT);
#pragma unroll
            for (int m = 0; m < 4; ++m) { const int i = 16 * m + fr;
#pragma unroll
                for (int bj = 0; bj < 2; ++bj) { const int tok = u.pn * 256 + bj * 128 + wc * 32 + 8 * fq; f32x4 lo[2], hi[2];
#pragma unroll
                    for (int n = 0; n < 2; ++n) { const f32x4 c = *(const f32x4*)(cosT + (size_t)i * T_ + tok + 4 * n), s = *(const f32x4*)(sinT + (size_t)i * T_ + tok + 4 * n);
                        const f32x4 x1 = acc[0][bj][m][n], x2 = acc[1][bj][m][n]; lo[n] = x1 * c - x2 * s; hi[n] = x2 * c + x1 * s; }
                    bf16_t* rp = O + (size_t)(rowt + wr * 128 + i) * T_ + tok;
                    *(u32x4*)rp = pack8(lo[0], lo[1]); *(u32x4*)(rp + (size_t)64 * T_) = pack8(hi[0], hi[1]); } }
        } else {
            bf16_t* O = (bf16_t*)(ws + (layer == 0 ? (kind == 1 ? WS_RVT : WS_HVT) : (kind == 0 ? WS_SVT : WS_DVT)));
#pragma unroll
            for (int ai = 0; ai < 2; ++ai)
#pragma unroll
                for (int m = 0; m < 4; ++m) { const int row = rowt + ai * 128 + wr * 64 + m * 16 + fr;
#pragma unroll
                    for (int bj = 0; bj < 2; ++bj) { const int tok = u.pn * 256 + bj * 128 + wc * 32 + 8 * fq;
                        *(u32x4*)(O + (size_t)row * T_ + tok) = pack8(acc[ai][bj][m][0], acc[ai][bj][m][1]); } }
        }
    }
};
struct OutRes {
    static constexpr bool PERM = true;
    const float* base; float* out;
    __device__ __forceinline__ void operator()(Acc acc, const Unit& u, int wr, int wc, int fr, int fq) const {
#pragma unroll
        for (int ai = 0; ai < 2; ++ai)
#pragma unroll
            for (int m = 0; m < 4; ++m) { const size_t row = (size_t)(u.pm * 256 + ai * 128 + wr * 64 + m * 16 + fr);
#pragma unroll
                for (int bj = 0; bj < 2; ++bj) { const int col = u.pn * 256 + bj * 128 + wc * 32 + 8 * fq;
#pragma unroll
                    for (int n = 0; n < 2; ++n) { const f32x4 b = *(const f32x4*)(base + row * DM + col + 4 * n); *(f32x4*)(out + row * DM + col + 4 * n) = b + acc[ai][bj][m][n]; } } }
    }
};
struct L1N {
    static constexpr bool PERM = true;
    unsigned char* ws; const float* cosd; const float* sind; const float* qg; const float* kg;
    __device__ __forceinline__ void operator()(Acc acc, const Unit& u, int wr, int wc, int fr, int fq) const {
        const int kind = u.pn >> 1, colt = (u.pn & 1) * 256;
        if (kind < 2) {
            bf16_t* O = (bf16_t*)(ws + (kind == 0 ? WS_SQ : WS_SK)); const float sc = kind == 0 ? 0.08838834764831845f : 1.0f;
#pragma unroll
            for (int ai = 0; ai < 2; ++ai)
#pragma unroll
                for (int m = 0; m < 4; ++m) { const int row = u.pm * 256 + ai * 128 + wr * 64 + m * 16 + fr;
#pragma unroll
                    for (int bj = 0; bj < 2; ++bj) { const int col = colt + bj * 128 + wc * 32 + 8 * fq;
                        *(u32x4*)(O + (size_t)row * 512 + col) = pack8(acc[ai][bj][m][0] * sc, acc[ai][bj][m][1] * sc); } }
        } else {
            bf16_t* O = (bf16_t*)(ws + (kind == 2 ? WS_DQ : WS_DK)); const float* gn = kind == 2 ? qg : kg; const float sc = kind == 2 ? 0.125f : 1.0f;
            f32x4 g[2][2];
#pragma unroll
            for (int bj = 0; bj < 2; ++bj)
#pragma unroll
                for (int n = 0; n < 2; ++n) g[bj][n] = *(const f32x4*)(gn + 32 * bj + 8 * fq + 4 * n);
#pragma unroll
            for (int ai = 0; ai < 2; ++ai)
#pragma unroll
                for (int m = 0; m < 4; ++m) { const int row = u.pm * 256 + ai * 128 + wr * 64 + m * 16 + fr; float ss = 0.f;
#pragma unroll
                    for (int bj = 0; bj < 2; ++bj)
#pragma unroll
                        for (int n = 0; n < 2; ++n) { const f32x4 v = acc[ai][bj][m][n]; ss += (v[0] * v[0] + v[1] * v[1]) + (v[2] * v[2] + v[3] * v[3]); }
                    ss += __shfl_xor(ss, 16); ss += __shfl_xor(ss, 32);
                    const float rstd = rsqrtf(ss * (1.0f / 64.0f) + EPS); f32x4 lo[2], hi[2];
#pragma unroll
                    for (int n = 0; n < 2; ++n) { const f32x4 c = *(const f32x4*)(cosd + (size_t)row * 32 + 8 * fq + 4 * n), s = *(const f32x4*)(sind + (size_t)row * 32 + 8 * fq + 4 * n);
                        const f32x4 x1 = acc[ai][0][m][n] * rstd * g[0][n], x2 = acc[ai][1][m][n] * rstd * g[1][n]; lo[n] = (x1 * c - x2 * s) * sc; hi[n] = (x2 * c + x1 * s) * sc; }
                    bf16_t* rp = O + (size_t)row * 512 + colt + wc * 64 + 8 * fq;
                    *(u32x4*)rp = pack8(lo[0], lo[1]); *(u32x4*)(rp + 32) = pack8(hi[0], hi[1]); }
        }
    }
};
}
constexpr int NWAVES = 8;
constexpr int RING_OFF = 0, RING_BYTES = 131072;
constexpr int LDSCTL_OFF = 143360, MISC_OFF = LDSCTL_OFF + 320;
constexpr int LDS_BYTES = 147456;
#define GAS __attribute__((address_space(1)))
#define LAS __attribute__((address_space(3)))
typedef GAS unsigned gu32;
#define RLX_AGENT __ATOMIC_RELAXED, __HIP_MEMORY_SCOPE_AGENT
#define LDS_WAIT() asm volatile("s_waitcnt lgkmcnt(0)" ::: "memory")
#define VM_WAIT() asm volatile("s_waitcnt vmcnt(0)" ::: "memory")
constexpr int CW_BAR = 4096;
constexpr int CW_MOE = 16384;
#define XB_TMO      128
#define XB_XCNT(j)  (256  + 64 * (j))
#define XB_XSUB(j)  (1280 + 64 * (j))
#define XB_XGEN(j)  (2304 + 64 * (j))
#define XB_TOP      3328
#define XB_TOPGEN   3392
#define XCD_BAR_WORDS 3456
#define XB_SPIN_CAP (1u << 18)
__device__ __forceinline__ unsigned xb_ld(unsigned* p)              { return __hip_atomic_load(p, __ATOMIC_RELAXED, __HIP_MEMORY_SCOPE_AGENT); }
__device__ __forceinline__ unsigned xb_add(unsigned* p, unsigned v) { return __hip_atomic_fetch_add(p, v, __ATOMIC_RELAXED, __HIP_MEMORY_SCOPE_AGENT); }
__device__ __forceinline__ unsigned xb_xcc_id() { return (unsigned)__builtin_amdgcn_s_getreg((3 << 11) | 20) & 0xFu; }
#define XB_SPIN(cond, bar) do { unsigned _sp = 0; while (cond) { __builtin_amdgcn_s_sleep(1); \
    if ((++_sp & 255u) == 0u) { if (xb_ld(&(bar)[XB_TMO])) break; if (_sp > XB_SPIN_CAP) { atomicAdd(&(bar)[XB_TMO], 1u); break; } } } } while (0)
struct XcdBarrier { unsigned* bar; unsigned x; volatile LAS unsigned* st; };
__device__ __forceinline__ XcdBarrier xcd_barrier_post(unsigned* bar, volatile LAS unsigned* st) {
    XcdBarrier b; b.bar = bar; b.x = xb_xcc_id(); b.st = st;
    if (threadIdx.x == 0) (void)xb_add(&bar[XB_XCNT(b.x)], 1u);
    return b;
}
__device__ __forceinline__ void xcd_barrier_complete(unsigned* bar, unsigned x, unsigned& nloc, unsigned& nx) {
    const unsigned G = gridDim.x * gridDim.y * gridDim.z;
    unsigned sum, cnt, mine, sp = 0u;
    for (;;) {
        sum = 0u; cnt = 0u; mine = 0u;
#pragma unroll
        for (unsigned j = 0; j < 16; ++j) { const unsigned c = xb_ld(&bar[XB_XCNT(j)]); sum += c; cnt += (c > 0u) ? 1u : 0u; mine = (j == x) ? c : mine; }
        if (sum == G) break;
        __builtin_amdgcn_s_sleep(1);
        if ((++sp & 255u) == 0u) { if (xb_ld(&bar[XB_TMO])) break; if (sp > XB_SPIN_CAP) { atomicAdd(&bar[XB_TMO], 1u); break; } }
    }
    nloc = mine > 0u ? mine : 1u; nx = cnt > 0u ? cnt : 1u;
}
__device__ __forceinline__ void xcd_barrier(const XcdBarrier& b) {
    asm volatile("s_waitcnt vmcnt(0)" ::: "memory");
    __syncthreads();
    if (threadIdx.x == 0) {
        unsigned* bar = b.bar;
        __builtin_amdgcn_s_waitcnt(0);
        unsigned nloc = b.st[0], nx = b.st[1];
        if (nloc == 0u) { xcd_barrier_complete(bar, b.x, nloc, nx); b.st[0] = nloc; b.st[1] = nx; }
        const unsigned old = xb_add(&bar[XB_XSUB(b.x)], 1u);
        const unsigned gen = old / nloc;
        if (old + 1u == (gen + 1u) * nloc) {
            __builtin_amdgcn_fence(__ATOMIC_RELEASE, "agent");
            asm volatile("s_waitcnt vmcnt(0)" ::: "memory");
            const unsigned og = xb_add(&bar[XB_TOP], 1u);
            const unsigned tg = og / nx;
            if (og + 1u == (tg + 1u) * nx) xb_add(&bar[XB_TOPGEN], 1u);
            else XB_SPIN(xb_ld(&bar[XB_TOPGEN]) == tg, bar);
            __builtin_amdgcn_fence(__ATOMIC_ACQUIRE, "agent");
            xb_add(&bar[XB_XGEN(b.x)], 1u);
            asm volatile("s_waitcnt vmcnt(0)" ::: "memory");
        } else {
            XB_SPIN(xb_ld(&bar[XB_XGEN(b.x)]) == gen, bar);
            __builtin_amdgcn_fence(__ATOMIC_ACQUIRE, "agent");
            asm volatile("s_waitcnt vmcnt(0)" ::: "memory");
        }
    }
    __syncthreads();
}

__device__ __forceinline__ void row_op(const float* base, const float* addf, const bf16_t* Y, float* out, const float* gain, bf16_t* XN, int row, int lane) {
    float v[16]; float ss = 0.f;
#pragma unroll
    for (int j = 0; j < 4; ++j) {
        const int c0 = 256 * j + 4 * lane; f32x4 x = *(const f32x4*)(base + (size_t)row * DM + c0);
        if (addf) { const f32x4 a = *(const f32x4*)(addf + (size_t)row * DM + c0); x += a; }
        if (Y) {
#pragma unroll
            for (int k = 0; k < 2; ++k) { const u32x2 w = *(const u32x2*)(Y + ((size_t)(2 * row + k)) * DM + c0);
                x[0] += __uint_as_float(w.x << 16); x[1] += __uint_as_float(w.x & 0xffff0000u); x[2] += __uint_as_float(w.y << 16); x[3] += __uint_as_float(w.y & 0xffff0000u); } }
        if (out) *(f32x4*)(out + (size_t)row * DM + c0) = x;
#pragma unroll
        for (int i = 0; i < 4; ++i) { v[4 * j + i] = x[i]; ss += x[i] * x[i]; }
    }
    if (!XN) return;
    const float rstd = rsqrtf(wave_sum(ss) * (1.0f / DM) + EPS);
#pragma unroll
    for (int j = 0; j < 4; ++j) { const int c0 = 256 * j + 4 * lane; const f32x4 g = *(const f32x4*)(gain + c0);
        u32x2 w; w.x = pk2(v[4 * j] * rstd * g[0], v[4 * j + 1] * rstd * g[1]); w.y = pk2(v[4 * j + 2] * rstd * g[2], v[4 * j + 3] * rstd * g[3]);
        *(u32x2*)(XN + (size_t)row * DM + c0) = w; }
}

struct In {
    const float *x; const int* pos; const float *norm_mix, *norm_ffn, *w_in_ab, *w_out_ab, *ret_gnorm, *lb_logits, *hgrn_onorm, *w_in_cd, *w_out_cd, *qnorm, *knorm, *lq1, *lk1, *lq2, *lk2, *subln,
        *rgw, *rgb, *rew, *reb, *wgate, *wup, *wdown;
};
__device__ __forceinline__ void conv_core(const float* src, int ld, bf16_t* dst, int K, int k0) {
    f32x4 v[8];
#pragma unroll
    for (int j = 0; j < 8; ++j) v[j] = *(const f32x4*)(src + (size_t)(k0 + j) * ld);
#pragma unroll
    for (int i = 0; i < 4; ++i) { u32x4 o; o.x = pk2(v[0][i], v[1][i]); o.y = pk2(v[2][i], v[3][i]); o.z = pk2(v[4][i], v[5][i]); o.w = pk2(v[6][i], v[7][i]);
        *(u32x4*)(dst + (size_t)i * K + k0) = o; }
}
constexpr int CV_S0 = 144 * 16, CV_S1 = 32 * 16, CV_S2 = 96 * 16, CV_S3 = 32 * 16, CV_S4 = 64 * 512, CV_S5 = 64 * 256;
constexpr int CV_TOTAL = CV_S0 + CV_S1 + CV_S2 + CV_S3 + CV_S4 + CV_S5;
constexpr size_t MOE_L_BYTES = 96 * MiB, MOE_W2_OFF = 64 * MiB;
__device__ __forceinline__ void conv_item(const In& I, unsigned char* ws, int it, int lane) {
    const int kq = lane & 7, ng = lane >> 3;
    if (it < CV_S0) {
        const int nb = it % 144, kb = it / 144, n = nb * 32 + ng * 4, p = n & 255; int split, half, rope;
        if (n < 3072) { const int s = n >> 9; split = s + (s >= 2) + (s >= 5); half = (n >> 8) & 1; rope = s < 2; }
        else { const int tt = (n - 3072) >> 9; split = tt == 0 ? 1 : tt == 1 ? 2 : 6; half = ((n - 3072) >> 8) & 1; rope = tt == 0; }
        const int cc = rope ? (128 * ((p >> 6) & 1) + 64 * (p >> 7) + (p & 63)) : p;
        conv_core(I.w_in_ab + split * 512 + half * 256 + cc, 4096, (bf16_t*)(ws + WS_WIN0T) + (size_t)n * 1024, 1024, kb * 64 + kq * 8); return; }
    it -= CV_S0;
    if (it < CV_S1) { const int nb = it % 32, kb = it / 32, n = nb * 32 + ng * 4; conv_core(I.w_out_ab + n, 1024, (bf16_t*)(ws + WS_WOUT0T) + (size_t)n * 1024, 1024, kb * 64 + kq * 8); return; }
    it -= CV_S1;
    if (it < CV_S2) {
        const int nb = it % 96, kb = it / 96, n = nb * 32 + ng * 4, p = n & 255; int split, half, dperm;
        if (n < 2048) { const int s = n >> 9; split = s + (s >= 2); half = (n >> 8) & 1; dperm = s >= 2; }
        else { const int tt = (n - 2048) >> 9; split = tt == 0 ? 2 : 5; half = ((n - 2048) >> 8) & 1; dperm = 0; }
        const int cc = dperm ? (64 * ((p >> 5) & 3) + 32 * (p >> 7) + (p & 31)) : p;
        conv_core(I.w_in_cd + split * 512 + half * 256 + cc, 3072, (bf16_t*)(ws + WS_WIN1T) + (size_t)n * 1024, 1024, kb * 64 + kq * 8); return; }
    it -= CV_S2;
    if (it < CV_S3) { const int nb = it % 32, kb = it / 32, n = nb * 32 + ng * 4; conv_core(I.w_out_cd + n, 1024, (bf16_t*)(ws + WS_WOUT1T) + (size_t)n * 1024, 1024, kb * 64 + kq * 8); return; }
    it -= CV_S3;
    if (it < CV_S4) {
        const int le = it >> 9, r = it & 511, nb = r & 31, kb = r >> 5, n = nb * 32 + ng * 4, p = n & 255;
        const float* W = ((p >> 7) ? I.wup : I.wgate) + (size_t)le * DM * EFF + 128 * (n >> 8) + (p & 127);
        conv_core(W, EFF, (bf16_t*)(ws + WS_MOEW + (size_t)(le >> 5) * MOE_L_BYTES) + ((size_t)(le & 31) * 1024 + n) * 1024, 1024, kb * 64 + kq * 8); return; }
    it -= CV_S4;
    { const int le = it >> 8, r = it & 255, nb = r & 31, kb = r >> 5, n = nb * 32 + ng * 4;
      conv_core(I.wdown + (size_t)le * EFF * DM + n, DM, (bf16_t*)(ws + WS_MOEW + (size_t)(le >> 5) * MOE_L_BYTES + MOE_W2_OFF) + ((size_t)(le & 31) * 1024 + n) * 512, 512, kb * 64 + kq * 8); }
}
constexpr int MOE_TAB_OFF = RING_BYTES;
constexpr size_t WRT_L = 2 * 48 * 1024;
__device__ __forceinline__ void build_wrt(const In& I, bf16_t* WRT, int gtid, int gthreads) {
    for (int idx = gtid; idx < 2 * 48 * 1024; idx += gthreads) { const int l = idx / (48 * 1024), r = idx % (48 * 1024), c = r >> 10, k = r & 1023;
        float v = 0.f; if (c < 4) v = I.rgw[((size_t)l * DM + k) * 4 + c]; else if (c < 36) v = I.rew[((size_t)l * DM + k) * 32 + (c - 4)];
        v *= I.norm_ffn[l * DM + k]; const unsigned h = f2bf(v); const float hf = __uint_as_float(h << 16);
        WRT[(size_t)l * WRT_L + r] = (bf16_t)h; WRT[(size_t)l * WRT_L + 48 * 1024 + r] = (bf16_t)f2bf(v - hf); }
}
__device__ __forceinline__ void route_group(LAS unsigned char* L, const float* X, const float* gain, const bf16_t* WRT, const float* bg, const float* be, bf16_t* XN,
                                            unsigned* cnt, int* LIST, float* GATEW, int* EXPID, int r0, int tid, int lane, int wave) {
    LAS float* part = (LAS float*)L;
    LAS float* ssp = (LAS float*)(L + 2 * 64 * 49 * 4);
    LAS float* srstd = ssp + 128;
    LAS int* lcnt = (LAS int*)(srstd + 64);
    LAS int* sbase = lcnt + 32;
    LAS int* sele = sbase + 32;
    LAS int* srank = sele + 128;
    LAS float* sgate = (LAS float*)(srank + 128);
    if (tid < 32) lcnt[tid] = 0;
    const int rg = wave & 3, kh = wave >> 2, r = lane & 15, q = lane >> 4;
    f32x4 acc[3]; for (int c = 0; c < 3; ++c) acc[c] = (f32x4){0.f, 0.f, 0.f, 0.f};
    float ss = 0.f;
    const float* xp = X + (size_t)(r0 + 16 * rg + r) * DM + 512 * kh + 8 * q;
    const bf16_t* wp = WRT + (size_t)r * 1024 + 512 * kh + 8 * q;
#pragma unroll 2
    for (int s = 0; s < 16; ++s) {
        const f32x4 x0 = *(const f32x4*)(xp + 32 * s), x1 = *(const f32x4*)(xp + 32 * s + 4);
        bf16x8 ah, al;
#pragma unroll
        for (int j = 0; j < 8; ++j) { const float x = j < 4 ? x0[j] : x1[j - 4]; ss += x * x; const unsigned h = f2bf(x); ah[j] = (short)h; al[j] = (short)f2bf(x - __uint_as_float(h << 16)); }
#pragma unroll
        for (int c = 0; c < 3; ++c) { const bf16x8 bh = *(const bf16x8*)(wp + (size_t)(16 * c) * 1024 + 32 * s), bl = *(const bf16x8*)(wp + (size_t)(48 + 16 * c) * 1024 + 32 * s);
            acc[c] = __builtin_amdgcn_mfma_f32_16x16x32_bf16(ah, bh, acc[c], 0, 0, 0); acc[c] = __builtin_amdgcn_mfma_f32_16x16x32_bf16(al, bh, acc[c], 0, 0, 0); acc[c] = __builtin_amdgcn_mfma_f32_16x16x32_bf16(ah, bl, acc[c], 0, 0, 0); }
    }
    ss += __shfl_xor(ss, 16); ss += __shfl_xor(ss, 32);
    if (q == 0) ssp[kh * 64 + 16 * rg + r] = ss;
#pragma unroll
    for (int c = 0; c < 3; ++c)
#pragma unroll
        for (int i = 0; i < 4; ++i) part[(kh * 64 + 16 * rg + 4 * q + i) * 49 + 16 * c + r] = acc[c][i];
    __syncthreads();
    if (tid < 64) {
        const int row = tid; const float rstd = rsqrtf((ssp[row] + ssp[64 + row]) * (1.0f / DM) + EPS); srstd[row] = rstd;
        const LAS float* p0 = part + row * 49; const LAS float* p1 = part + (64 + row) * 49;
        const float g0 = (p0[0] + p1[0]) * rstd + bg[0], g1 = (p0[1] + p1[1]) * rstd + bg[1], g2 = (p0[2] + p1[2]) * rstd + bg[2], g3 = (p0[3] + p1[3]) * rstd + bg[3];
        int gs = 0; float gm = g0; if (g1 > gm) { gm = g1; gs = 1; } if (g2 > gm) { gm = g2; gs = 2; } if (g3 > gm) { gm = g3; gs = 3; }
        const float pg = 1.0f / (__expf(g0 - gm) + __expf(g1 - gm) + __expf(g2 - gm) + __expf(g3 - gm));
        float v1 = -3.0e38f, v2 = -3.0e38f; int i1 = 0, i2 = 0;
#pragma unroll
        for (int i = 0; i < 8; ++i) { const int c = 4 + gs * 8 + i; const float ev = (p0[c] + p1[c]) * rstd + be[gs * 8 + i];
            if (ev > v1) { v2 = v1; i2 = i1; v1 = ev; i1 = i; } else if (ev > v2) { v2 = ev; i2 = i; } }
        const float e2 = __expf(v2 - v1); const float pa = 1.0f / (1.0f + e2), pb = e2 / (1.0f + e2);
        const int ea = gs * 8 + i1, eb = gs * 8 + i2;
        sele[2 * row] = ea; sele[2 * row + 1] = eb; sgate[2 * row] = pg * pa; sgate[2 * row + 1] = pg * pb;
        srank[2 * row] = __hip_atomic_fetch_add(&lcnt[ea], 1, __ATOMIC_RELAXED, __HIP_MEMORY_SCOPE_WORKGROUP); srank[2 * row + 1] = __hip_atomic_fetch_add(&lcnt[eb], 1, __ATOMIC_RELAXED, __HIP_MEMORY_SCOPE_WORKGROUP);
    }
    __syncthreads();
    if (tid < 32) sbase[tid] = (int)__hip_atomic_fetch_add(cnt + tid, (unsigned)lcnt[tid], __ATOMIC_RELAXED, __HIP_MEMORY_SCOPE_AGENT);
    __syncthreads();
    if (tid < 128) { const int e = sele[tid], pair = 2 * r0 + tid; LIST[(size_t)e * T_ + sbase[e] + srank[tid]] = pair; GATEW[pair] = sgate[tid]; EXPID[pair] = e; }
    for (int rr = 0; rr < 8; ++rr) { const int lr = wave * 8 + rr; const float rstd = srstd[lr]; const size_t row = (size_t)(r0 + lr);
#pragma unroll
        for (int j = 0; j < 4; ++j) { const int c0 = 256 * j + 4 * lane; const f32x4 x = *(const f32x4*)(X + row * DM + c0), g = *(const f32x4*)(gain + c0);
            u32x2 w; w.x = pk2(x[0] * rstd * g[0], x[1] * rstd * g[1]); w.y = pk2(x[2] * rstd * g[2], x[3] * rstd * g[3]); *(u32x2*)(XN + row * DM + c0) = w; } }
    __syncthreads();
}
struct MoeTabs { LAS int* cnt; LAS int* tile_e; LAS int* tile_r0; LAS int* nt; };
__device__ __forceinline__ MoeTabs moe_tabs(LAS unsigned char* L) { MoeTabs t; t.cnt = (LAS int*)(L + MOE_TAB_OFF); t.tile_e = t.cnt + 32; t.tile_r0 = t.tile_e + 192; t.nt = t.tile_r0 + 192; return t; }
__device__ __forceinline__ void moe_build(const MoeTabs& t, const unsigned* cnt, int tid) {
    if (tid < 32) t.cnt[tid] = (int)__hip_atomic_load(cnt + tid, __ATOMIC_RELAXED, __HIP_MEMORY_SCOPE_AGENT);
    __syncthreads();
    if (tid == 0) { int n = 0; for (int e = 0; e < 32; ++e) { const int c = t.cnt[e]; for (int r0 = 0; r0 < c; r0 += 256) { t.tile_e[n] = e; t.tile_r0[n] = r0; ++n; } } t.nt[0] = n; }
    __syncthreads();
}
struct MoeOrder {
    MoeTabs t; const int* LIST; int G, c, K, gather; size_t wexp;
    __device__ bool next(int i, pg8::Unit& u) const { const int Lx = i * G + c; if (Lx >= t.nt[0] * 4) return false; u.pm = Lx >> 2; u.pn = Lx & 3; return true; }
    __device__ __forceinline__ unsigned arow(const pg8::Unit& u, int r) const {
        if (!gather) return (unsigned)(u.pm * 256 + r);
        const int e = t.tile_e[u.pm], pos = t.tile_r0[u.pm] + r; return pos < t.cnt[e] ? (unsigned)(LIST[(size_t)e * T_ + pos] >> 1) : 0u; }
    __device__ __forceinline__ size_t boff(const pg8::Unit& u) const { return (size_t)t.tile_e[u.pm] * wexp + (size_t)u.pn * 256 * K * 2; }
};
namespace epi {
struct Moe1 {
    static constexpr bool PERM = true; bf16_t* ACT;
    __device__ __forceinline__ void operator()(Acc acc, const Unit& u, int wr, int wc, int fr, int fq) const {
#pragma unroll
        for (int ai = 0; ai < 2; ++ai)
#pragma unroll
            for (int m = 0; m < 4; ++m) { const size_t row = (size_t)(u.pm * 256 + ai * 128 + wr * 64 + m * 16 + fr);
                *(u32x4*)(ACT + row * EFF + u.pn * 128 + wc * 32 + 8 * fq) = pack8(silu4(acc[ai][0][m][0]) * acc[ai][1][m][0], silu4(acc[ai][0][m][1]) * acc[ai][1][m][1]); }
    }
};
struct Moe2 {
    static constexpr bool PERM = true; bf16_t* Y; const int* LIST; const float* GATEW; MoeTabs t;
    __device__ __forceinline__ void operator()(Acc acc, const Unit& u, int wr, int wc, int fr, int fq) const {
        const int e = t.tile_e[u.pm], r00 = t.tile_r0[u.pm], ce = t.cnt[e];
#pragma unroll
        for (int ai = 0; ai < 2; ++ai)
#pragma unroll
            for (int m = 0; m < 4; ++m) { const int pos = r00 + ai * 128 + wr * 64 + m * 16 + fr;
                if (pos < ce) { const int pair = LIST[(size_t)e * T_ + pos]; const float gw = GATEW[pair];
#pragma unroll
                    for (int bj = 0; bj < 2; ++bj) *(u32x4*)(Y + (size_t)pair * DM + u.pn * 256 + bj * 128 + wc * 32 + 8 * fq) = pack8(acc[ai][bj][m][0] * gw, acc[ai][bj][m][1] * gw); } }
    }
};
}
template <int NJ, int KS>
__device__ __forceinline__ void mm_rb(f32x4 (&acc)[NJ], const bf16x8 (&a)[KS], const LAS bf16_t* B, int ldb, int lane) {
    const LAS bf16_t* bp = B + (lane & 15) * ldb + 8 * (lane >> 4);
#pragma unroll
    for (int j = 0; j < NJ; ++j)
#pragma unroll
        for (int s = 0; s < KS; ++s) { const bf16x8 b = *(const LAS bf16x8*)(bp + 16 * j * ldb + 32 * s); acc[j] = __builtin_amdgcn_mfma_f32_16x16x32_bf16(b, a[s], acc[j], 0, 0, 0); }
}
template <int KS> __device__ __forceinline__ void ld_afrag(bf16x8 (&a)[KS], const LAS bf16_t* A, int lda, int lane) {
    const LAS bf16_t* ap = A + (lane & 15) * lda + 8 * (lane >> 4);
#pragma unroll
    for (int s = 0; s < KS; ++s) a[s] = *(const LAS bf16x8*)(ap + 32 * s);
}
template <int KS> __device__ __forceinline__ void ld_afrag_g(bf16x8 (&a)[KS], const bf16_t* A, size_t ld, int lane) {
    const unsigned voff = ((unsigned)(lane & 15) * (unsigned)ld + 8u * (unsigned)(lane >> 4)) * 2u;
#pragma unroll
    for (int s = 0; s < KS; ++s) a[s] = *(const bf16x8*)((const char*)A + voff + 64 * s);
}
template <int ROWS, int COLS> __device__ __forceinline__ void stage_tile(LAS bf16_t* dst, int lds_ld, const bf16_t* src, size_t ld, int tid) {
    constexpr int PPR = COLS / 8, TOTAL = ROWS * PPR, RSTEP = 512 / PPR; static_assert(TOTAL % 512 == 0, "tile pieces");
    const int r0 = tid / PPR, c = (tid % PPR) * 8; const unsigned voff = ((unsigned)r0 * (unsigned)ld + (unsigned)c) * 2u; LAS bf16_t* dp = dst + r0 * lds_ld + c;
#pragma unroll
    for (int k = 0; k < TOTAL / 512; ++k) *(LAS u32x4*)(dp + k * RSTEP * lds_ld) = *(const u32x4*)((const char*)(src + (size_t)k * RSTEP * ld) + voff);
}
constexpr int LDT = 136;
constexpr int LDH = 72;
__device__ __forceinline__ float ret_l2g(int h) { return __log2f(1.0f - exp2f(-5.0f - (float)h)); }

__device__ __forceinline__ void ret_local(LAS unsigned char* L, unsigned char* ws, int unit, int tid, int lane, int wave) {
    const int bh = unit >> 5, c = unit & 31, b = bh >> 2, h = bh & 3; const size_t tok0 = (size_t)b * SEQ + c * 128;
    LAS bf16_t* KT = (LAS bf16_t*)L;
    const bf16_t* RKT = (const bf16_t*)(ws + WS_RKT) + (size_t)(h * 128) * T_ + tok0; const bf16_t* RVT = (const bf16_t*)(ws + WS_RVT) + (size_t)(h * 128) * T_ + tok0;
    const float l2g = ret_l2g(h);
#pragma unroll
    for (int p0 = 0; p0 < 2048; p0 += 512) { const int p = p0 + tid, r = p >> 4, s0 = (p & 15) * 8; const u32x4 w = *(const u32x4*)(RKT + (size_t)r * T_ + s0); u32x4 o;
#pragma unroll
        for (int k = 0; k < 4; ++k) { const unsigned x = w[k]; const float f0 = exp2f(l2g * (float)(127 - (s0 + 2 * k))), f1 = exp2f(l2g * (float)(126 - (s0 + 2 * k)));
            o[k] = pk2(__uint_as_float(x << 16) * f0, __uint_as_float(x & 0xffff0000u) * f1); }
        *(LAS u32x4*)(KT + r * LDT + s0) = o; }
    bf16x8 a[4]; ld_afrag_g<4>(a, RVT + (size_t)(16 * wave) * T_, T_, lane);
    __syncthreads();
    f32x4 acc[8]; for (int j = 0; j < 8; ++j) acc[j] = (f32x4){0.f, 0.f, 0.f, 0.f};
    mm_rb<8, 4>(acc, a, KT, LDT, lane);
    bf16_t* RS = (bf16_t*)(ws + WS_RS) + ((size_t)unit * 128 + 16 * wave + (lane & 15)) * 128 + 4 * (lane >> 4);
#pragma unroll
    for (int j = 0; j < 8; ++j) { u32x2 w; w.x = pk2(acc[j][0], acc[j][1]); w.y = pk2(acc[j][2], acc[j][3]); *(u32x2*)(RS + 16 * j) = w; }
    __syncthreads();
}
struct HgPrep { float lf[16]; float b[16]; float blast, bmid; };
__device__ __forceinline__ void hg_cumsum(HgPrep& P, LAS float* tot  , const float* LOGF  , int tid) {
    const int d = tid & 127, qt = tid >> 7; float run = 0.f;
#pragma unroll
    for (int i = 0; i < 16; ++i) { P.lf[i] = LOGF[(size_t)(16 * qt + i) * 512 + d]; run += P.lf[i]; P.b[i] = run; }
    tot[qt * 128 + d] = run;
    __syncthreads();
    const float t0 = tot[d], t1 = tot[128 + d], t2 = tot[256 + d], t3 = tot[384 + d];
    const float off = (qt > 0 ? t0 : 0.f) + (qt > 1 ? t1 : 0.f) + (qt > 2 ? t2 : 0.f);
#pragma unroll
    for (int i = 0; i < 16; ++i) P.b[i] += off;
    P.blast = (t0 + t1) + (t2 + t3); P.bmid = t0 + t1;
}
__device__ __forceinline__ void hg_local(LAS unsigned char* L, unsigned char* ws, int unit, int tid, int lane, int wave) {
    const int bh = unit >> 6, c = unit & 63, b = bh >> 2, h = bh & 3; const size_t tok0 = (size_t)b * SEQ + c * 64;
    LAS bf16_t* KH = (LAS bf16_t*)L;
    LAS float* tot = (LAS float*)(L + 128 * LDH * 2);
    HgPrep P; hg_cumsum(P, tot, (const float*)(ws + WS_LOGF) + tok0 * 512 + h * 128, tid);
    const int d = tid & 127, qt = tid >> 7;
    { u32x4 o[2];
#pragma unroll
      for (int k = 0; k < 8; ++k) { const float k0 = (1.0f - __expf(P.lf[2 * k])) * __expf(P.blast - P.b[2 * k]), k1 = (1.0f - __expf(P.lf[2 * k + 1])) * __expf(P.blast - P.b[2 * k + 1]); o[k >> 2][k & 3] = pk2(k0, k1); }
      *(LAS u32x4*)(KH + d * LDH + 16 * qt) = o[0]; *(LAS u32x4*)(KH + d * LDH + 16 * qt + 8) = o[1]; }
    if (qt == 0) ((float*)(ws + WS_HDEC))[(size_t)unit * 128 + d] = __expf(P.blast);
    const bf16_t* HVT = (const bf16_t*)(ws + WS_HVT) + (size_t)(h * 128) * T_ + tok0;
    bf16x8 a[2]; ld_afrag_g<2>(a, HVT + (size_t)(16 * wave) * T_, T_, lane);
    __syncthreads();
    f32x4 acc[8]; for (int j = 0; j < 8; ++j) acc[j] = (f32x4){0.f, 0.f, 0.f, 0.f};
    mm_rb<8, 2>(acc, a, KH, LDH, lane);
    bf16_t* HS = (bf16_t*)(ws + WS_HS) + ((size_t)unit * 128 + 16 * wave + (lane & 15)) * 128 + 4 * (lane >> 4);
#pragma unroll
    for (int j = 0; j < 8; ++j) { u32x2 w; w.x = pk2(acc[j][0], acc[j][1]); w.y = pk2(acc[j][2], acc[j][3]); *(u32x2*)(HS + 16 * j) = w; }
    __syncthreads();
}
__device__ __forceinline__ void scan_states(unsigned char* ws, int g) {
    const int bh = g >> 13, el = (g & 8191) * 2, h = bh & 3, d = el & 127;
    { unsigned* p = (unsigned*)((bf16_t*)(ws + WS_RS) + (size_t)bh * 32 * 16384 + el); const float dec = exp2f(128.0f * ret_l2g(h)); float s0 = 0.f, s1 = 0.f;
#pragma unroll 8
      for (int c = 0; c < 32; ++c) { const unsigned v = p[(size_t)c * 8192]; p[(size_t)c * 8192] = pk2(s0, s1); s0 = s0 * dec + __uint_as_float(v << 16); s1 = s1 * dec + __uint_as_float(v & 0xffff0000u); } }
    { unsigned* p = (unsigned*)((bf16_t*)(ws + WS_HS) + (size_t)bh * 64 * 16384 + el); const float* dp = (const float*)(ws + WS_HDEC) + (size_t)bh * 64 * 128 + d; float s0 = 0.f, s1 = 0.f;
#pragma unroll 8
      for (int c = 0; c < 64; ++c) { const unsigned v = p[(size_t)c * 8192]; const float d0 = dp[c * 128], d1 = dp[c * 128 + 1]; p[(size_t)c * 8192] = pk2(s0, s1);
          s0 = s0 * d0 + __uint_as_float(v << 16); s1 = s1 * d1 + __uint_as_float(v & 0xffff0000u); } }
}
__device__ __forceinline__ void ret_out(LAS unsigned char* L, unsigned char* ws, const float* gain, int unit, int tid, int lane, int wave) {
    const int bh = unit >> 5, c = unit & 31, b = bh >> 2, h = bh & 3; const size_t tok0 = (size_t)b * SEQ + c * 128;
    LAS bf16_t* Ks = (LAS bf16_t*)L; LAS bf16_t* VTs = Ks + 128 * LDT; LAS bf16_t* STs = VTs + 128 * LDT; LAS bf16_t* Ps = STs + 128 * LDT;
    stage_tile<128, 128>(Ks, LDT, (const bf16_t*)(ws + WS_RK) + tok0 * 512 + h * 128, 512, tid);
    stage_tile<128, 128>(VTs, LDT, (const bf16_t*)(ws + WS_RVT) + (size_t)(h * 128) * T_ + tok0, T_, tid);
    stage_tile<128, 128>(STs, LDT, (const bf16_t*)(ws + WS_RS) + (size_t)unit * 16384, 128, tid);
    bf16x8 aq[4]; ld_afrag_g<4>(aq, (const bf16_t*)(ws + WS_RQ) + (tok0 + 16 * wave) * 512 + h * 128, 512, lane);
    __syncthreads();
    const int r = lane & 15, q = lane >> 4, tl = 16 * wave + r; const float l2g = ret_l2g(h);
    f32x4 acc[8]; for (int j = 0; j < 8; ++j) acc[j] = (f32x4){0.f, 0.f, 0.f, 0.f};
    mm_rb<8, 4>(acc, aq, Ks, LDT, lane);
#pragma unroll
    for (int j = 0; j < 8; ++j) { float p[4];
#pragma unroll
        for (int i = 0; i < 4; ++i) { const int s = 16 * j + 4 * q + i; p[i] = (s <= tl) ? acc[j][i] * exp2f(l2g * (float)(tl - s)) : 0.f; }
        u32x2 w; w.x = pk2(p[0], p[1]); w.y = pk2(p[2], p[3]); *(LAS u32x2*)(Ps + tl * LDT + 16 * j + 4 * q) = w; }
    for (int j = 0; j < 8; ++j) acc[j] = (f32x4){0.f, 0.f, 0.f, 0.f};
    mm_rb<8, 4>(acc, aq, STs, LDT, lane);
    const float qd = exp2f(l2g * (float)(tl + 1));
#pragma unroll
    for (int j = 0; j < 8; ++j) acc[j] *= qd;
    __syncthreads();
    bf16x8 ap[4]; ld_afrag<4>(ap, Ps + 16 * wave * LDT, LDT, lane);
    mm_rb<8, 4>(acc, ap, VTs, LDT, lane);
    float ss = 0.f;
#pragma unroll
    for (int j = 0; j < 8; ++j) ss += (acc[j][0] * acc[j][0] + acc[j][1] * acc[j][1]) + (acc[j][2] * acc[j][2] + acc[j][3] * acc[j][3]);
    ss += __shfl_xor(ss, 16); ss += __shfl_xor(ss, 32);
    const float rstd = rsqrtf(ss * (1.0f / 128.0f) + EPS);
    const size_t row = tok0 + tl; const bf16_t* RG = (const bf16_t*)(ws + WS_RG) + row * 512 + h * 128 + 4 * q; bf16_t* MX = (bf16_t*)(ws + WS_MIX) + row * DM + h * 128 + 4 * q;
#pragma unroll
    for (int j = 0; j < 8; ++j) { const u32x2 g = *(const u32x2*)(RG + 16 * j); const f32x4 gn = *(const f32x4*)(gain + h * 128 + 16 * j + 4 * q); u32x2 w;
        w.x = pk2(acc[j][0] * rstd * gn[0] * __uint_as_float(g.x << 16), acc[j][1] * rstd * gn[1] * __uint_as_float(g.x & 0xffff0000u));
        w.y = pk2(acc[j][2] * rstd * gn[2] * __uint_as_float(g.y << 16), acc[j][3] * rstd * gn[3] * __uint_as_float(g.y & 0xffff0000u)); *(u32x2*)(MX + 16 * j) = w; }
    __syncthreads();
}
__device__ __forceinline__ void hg_out(LAS unsigned char* L, unsigned char* ws, const float* gain, int unit, int tid, int lane, int wave) {
    const int bh = unit >> 6, c = unit & 63, b = bh >> 2, h = bh & 3; const size_t tok0 = (size_t)b * SEQ + c * 64;
    LAS bf16_t* Qr = (LAS bf16_t*)L; LAS bf16_t* Kr = Qr + 64 * LDT; LAS bf16_t* Qa = Kr + 64 * LDT; LAS bf16_t* STs = Qa + 64 * LDT; LAS bf16_t* VTs = STs + 128 * LDT; LAS bf16_t* Ps = VTs + 128 * LDH;
    LAS float* tot = (LAS float*)(Ps + 64 * LDH); LAS float* ssx = tot + 512;
    stage_tile<128, 128>(STs, LDT, (const bf16_t*)(ws + WS_HS) + (size_t)unit * 16384, 128, tid);
    stage_tile<128, 64>(VTs, LDH, (const bf16_t*)(ws + WS_HVT) + (size_t)(h * 128) * T_ + tok0, T_, tid);
    HgPrep P; hg_cumsum(P, tot, (const float*)(ws + WS_LOGF) + tok0 * 512 + h * 128, tid);
    { const int d = tid & 127, qt = tid >> 7; const bf16_t* HQ = (const bf16_t*)(ws + WS_HQ) + tok0 * 512 + h * 128 + d;
#pragma unroll
      for (int i = 0; i < 16; ++i) { const int t = 16 * qt + i; const float qv = bf2f(HQ[(size_t)t * 512]); const float kk = 1.0f - __expf(P.lf[i]);
          Qr[t * LDT + d] = (bf16_t)f2bf(qv * __expf(P.b[i] - P.bmid)); Kr[t * LDT + d] = (bf16_t)f2bf(kk * __expf(P.bmid - P.b[i])); Qa[t * LDT + d] = (bf16_t)f2bf(qv * __expf(P.b[i])); } }
    __syncthreads();
    const int wr = wave & 3, wc = wave >> 2, r = lane & 15, q = lane >> 4, tl = 16 * wr + r;
    { bf16x8 a[4]; ld_afrag<4>(a, Qr + 16 * wr * LDT, LDT, lane); f32x4 sc[2]; sc[0] = (f32x4){0.f, 0.f, 0.f, 0.f}; sc[1] = sc[0];
      mm_rb<2, 4>(sc, a, Kr + 32 * wc * LDT, LDT, lane);
#pragma unroll
      for (int j = 0; j < 2; ++j) { float p[4];
#pragma unroll
          for (int i = 0; i < 4; ++i) { const int s = 32 * wc + 16 * j + 4 * q + i; p[i] = (s <= tl) ? sc[j][i] : 0.f; }
          u32x2 w; w.x = pk2(p[0], p[1]); w.y = pk2(p[2], p[3]); *(LAS u32x2*)(Ps + tl * LDH + 32 * wc + 16 * j + 4 * q) = w; } }
    f32x4 acc[4]; for (int j = 0; j < 4; ++j) acc[j] = (f32x4){0.f, 0.f, 0.f, 0.f};
    { bf16x8 a[4]; ld_afrag<4>(a, Qa + 16 * wr * LDT, LDT, lane); mm_rb<4, 4>(acc, a, STs + 64 * wc * LDT, LDT, lane); }
    __syncthreads();
    { bf16x8 a[2]; ld_afrag<2>(a, Ps + 16 * wr * LDH, LDH, lane); mm_rb<4, 2>(acc, a, VTs + 64 * wc * LDH, LDH, lane); }
    float ss = 0.f;
#pragma unroll
    for (int j = 0; j < 4; ++j) ss += (acc[j][0] * acc[j][0] + acc[j][1] * acc[j][1]) + (acc[j][2] * acc[j][2] + acc[j][3] * acc[j][3]);
    ss += __shfl_xor(ss, 16); ss += __shfl_xor(ss, 32);
    if (q == 0) ssx[wc * 64 + tl] = ss;
    __syncthreads();
    const float rstd = rsqrtf((ssx[tl] + ssx[64 + tl]) * (1.0f / 128.0f) + EPS);
    const size_t row = tok0 + tl; const bf16_t* HG = (const bf16_t*)(ws + WS_HG) + row * 512 + h * 128 + 64 * wc + 4 * q; bf16_t* MX = (bf16_t*)(ws + WS_MIX) + row * DM + 512 + h * 128 + 64 * wc + 4 * q;
#pragma unroll
    for (int j = 0; j < 4; ++j) { const u32x2 g = *(const u32x2*)(HG + 16 * j); const f32x4 gn = *(const f32x4*)(gain + h * 128 + 64 * wc + 16 * j + 4 * q); u32x2 w;
        w.x = pk2(acc[j][0] * rstd * gn[0] * __uint_as_float(g.x << 16), acc[j][1] * rstd * gn[1] * __uint_as_float(g.x & 0xffff0000u));
        w.y = pk2(acc[j][2] * rstd * gn[2] * __uint_as_float(g.y << 16), acc[j][3] * rstd * gn[3] * __uint_as_float(g.y & 0xffff0000u)); *(u32x2*)(MX + 16 * j) = w; }
    __syncthreads();
}
constexpr float SB_RMAX = 40.0f;
__device__ __forceinline__ void sb_unit(LAS unsigned char* L, unsigned char* ws, int bh, int qb, int tid, int lane, int wave) {
    const int b = bh >> 2, h = bh & 3; const size_t tokb = (size_t)b * SEQ;
    LAS bf16_t* Ks = (LAS bf16_t*)L; LAS bf16_t* VTs = Ks + 128 * LDT; LAS bf16_t* Ps = VTs + 128 * LDT; LAS float* rmin = (LAS float*)(Ps + 128 * LDT);
    const bf16_t* SK = (const bf16_t*)(ws + WS_SK) + h * 128; const bf16_t* SVT = (const bf16_t*)(ws + WS_SVT) + (size_t)(h * 128) * T_;
    const int r = lane & 15, q = lane >> 4, tl = 16 * wave + r, t = qb * 128 + tl;
    bf16x8 aq[4]; ld_afrag_g<4>(aq, (const bf16_t*)(ws + WS_SQ) + (tokb + qb * 128 + 16 * wave) * 512 + h * 128, 512, lane);
    f32x4 o[8]; for (int j = 0; j < 8; ++j) o[j] = (f32x4){0.f, 0.f, 0.f, 0.f};
    float R = 0.f; int it = 0;
    for (int kb = qb; kb >= 0; --kb, ++it) {
        stage_tile<128, 128>(Ks, LDT, SK + (tokb + kb * 128) * 512, 512, tid);
        stage_tile<128, 128>(VTs, LDT, SVT + tokb + kb * 128, T_, tid);
        __syncthreads();
        f32x4 z[8]; for (int j = 0; j < 8; ++j) z[j] = (f32x4){0.f, 0.f, 0.f, 0.f};
        mm_rb<8, 4>(z, aq, Ks, LDT, lane);
        float G[8]; f32x4 sp[8];
#pragma unroll
        for (int j = 0; j < 8; ++j) { float g = 0.f;
#pragma unroll
            for (int i = 0; i < 4; ++i) { const int s = kb * 128 + 16 * j + 4 * q + i; const float zz = z[j][i]; const float v = (s < t) ? (fmaxf(zz, 0.f) + __logf(1.0f + __expf(-fabsf(zz)))) : 0.f; sp[j][i] = v; g += v; }
            G[j] = g; }
        float J = 0.f;
#pragma unroll
        for (int j = 7; j >= 0; --j) { const float g = G[j]; const float s1 = g + __shfl_xor(g, 16); const float s2 = __shfl_xor(s1, 32);
            const float gq = ((q & 1) == 0 ? (s1 - g) : 0.f) + (q < 2 ? s2 : 0.f);
            const float base = R + J + gq;
            const float a3 = base, a2 = a3 + sp[j][3], a1 = a2 + sp[j][2], a0 = a1 + sp[j][1];
            float p[4]; const float af[4] = {a0, a1, a2, a3};
#pragma unroll
            for (int i = 0; i < 4; ++i) { const int s = kb * 128 + 16 * j + 4 * q + i; p[i] = (s < t) ? __expf(z[j][i] - sp[j][i] - af[i]) : 0.f; }
            u32x2 w; w.x = pk2(p[0], p[1]); w.y = pk2(p[2], p[3]); *(LAS u32x2*)(Ps + tl * LDT + 16 * j + 4 * q) = w;
            J += s1 + s2; }
        R += J;
        float rm = R; rm = fminf(rm, __shfl_xor(rm, 1)); rm = fminf(rm, __shfl_xor(rm, 2)); rm = fminf(rm, __shfl_xor(rm, 4)); rm = fminf(rm, __shfl_xor(rm, 8));
        if (lane == 0) rmin[(it & 1) * 8 + wave] = rm;
        __syncthreads();
        bf16x8 ap[4]; ld_afrag<4>(ap, Ps + 16 * wave * LDT, LDT, lane);
        mm_rb<8, 4>(o, ap, VTs, LDT, lane);
        float m = rmin[(it & 1) * 8];
#pragma unroll
        for (int w2 = 1; w2 < 8; ++w2) m = fminf(m, rmin[(it & 1) * 8 + w2]);
        __syncthreads();
        if (m > SB_RMAX) break;
    }
    bf16_t* MX = (bf16_t*)(ws + WS_MIX) + (tokb + t) * DM + h * 128 + 4 * q;
#pragma unroll
    for (int j = 0; j < 8; ++j) { u32x2 w; w.x = pk2(o[j][0], o[j][1]); w.y = pk2(o[j][2], o[j][3]); *(u32x2*)(MX + 16 * j) = w; }
}
__device__ __forceinline__ void diff_unit(LAS unsigned char* L, unsigned char* ws, const In& I, int bh, int qb, int tid, int lane, int wave) {
    const int b = bh >> 2, h = bh & 3; const size_t tokb = (size_t)b * SEQ;
    LAS bf16_t* Ks = (LAS bf16_t*)L; LAS bf16_t* VTs = Ks + 128 * LDT; LAS bf16_t* Ps = VTs + 128 * LDT;
    const bf16_t* DK = (const bf16_t*)(ws + WS_DK) + h * 128; const bf16_t* DVT = (const bf16_t*)(ws + WS_DVT) + (size_t)(h * 128) * T_;
    const int r = lane & 15, q = lane >> 4, tl = 16 * wave + r, t = qb * 128 + tl;
    const float lam_init = 0.8f - 0.6f * __expf(-0.3f);
    const float lam = __expf(wave_sum(I.lq1[lane] * I.lk1[lane])) - __expf(wave_sum(I.lq2[lane] * I.lk2[lane])) + lam_init;
    bf16x8 aq[2][2]; { bf16x8 tmp[4]; ld_afrag_g<4>(tmp, (const bf16_t*)(ws + WS_DQ) + (tokb + qb * 128 + 16 * wave) * 512 + h * 128, 512, lane); aq[0][0] = tmp[0]; aq[0][1] = tmp[1]; aq[1][0] = tmp[2]; aq[1][1] = tmp[3]; }
    f32x4 o0[8], o1[8]; for (int j = 0; j < 8; ++j) { o0[j] = (f32x4){0.f, 0.f, 0.f, 0.f}; o1[j] = o0[j]; }
    float m0 = -1e30f, m1 = -1e30f, l0 = 0.f, l1 = 0.f;
    for (int kb = 0; kb <= qb; ++kb) {
        stage_tile<128, 128>(Ks, LDT, DK + (tokb + kb * 128) * 512, 512, tid);
        stage_tile<128, 128>(VTs, LDT, DVT + tokb + kb * 128, T_, tid);
        __syncthreads();
#pragma unroll
        for (int c = 0; c < 2; ++c) {
            f32x4 z[8]; for (int j = 0; j < 8; ++j) z[j] = (f32x4){0.f, 0.f, 0.f, 0.f};
            mm_rb<8, 2>(z, aq[c], Ks + 64 * c, LDT, lane);
            float mx = -1e30f;
#pragma unroll
            for (int j = 0; j < 8; ++j)
#pragma unroll
                for (int i = 0; i < 4; ++i) { const int s = kb * 128 + 16 * j + 4 * q + i; if (s > t) z[j][i] = -1e30f; mx = fmaxf(mx, z[j][i]); }
            mx = fmaxf(mx, __shfl_xor(mx, 16)); mx = fmaxf(mx, __shfl_xor(mx, 32));
            float& mr = c ? m1 : m0; float& lr = c ? l1 : l0;
            const float mn = fmaxf(mr, mx), al = __expf(mr - mn); mr = mn; float rs = 0.f;
#pragma unroll
            for (int j = 0; j < 8; ++j) { float p[4];
#pragma unroll
                for (int i = 0; i < 4; ++i) { p[i] = __expf(z[j][i] - mn); rs += p[i]; }
                u32x2 w; w.x = pk2(p[0], p[1]); w.y = pk2(p[2], p[3]); *(LAS u32x2*)(Ps + tl * LDT + 16 * j + 4 * q) = w; }
            rs += __shfl_xor(rs, 16); rs += __shfl_xor(rs, 32); lr = lr * al + rs;
            __syncthreads();
            bf16x8 ap[4]; ld_afrag<4>(ap, Ps + 16 * wave * LDT, LDT, lane);
            if (c == 0) { for (int j = 0; j < 8; ++j) o0[j] *= al; mm_rb<8, 4>(o0, ap, VTs, LDT, lane); } else { for (int j = 0; j < 8; ++j) o1[j] *= al; mm_rb<8, 4>(o1, ap, VTs, LDT, lane); }
            __syncthreads();
        }
    }
    const float i0 = 1.0f / l0, i1 = lam / l1; float ss = 0.f;
#pragma unroll
    for (int j = 0; j < 8; ++j) { o0[j] = o0[j] * i0 - o1[j] * i1; ss += (o0[j][0] * o0[j][0] + o0[j][1] * o0[j][1]) + (o0[j][2] * o0[j][2] + o0[j][3] * o0[j][3]); }
    ss += __shfl_xor(ss, 16); ss += __shfl_xor(ss, 32);
    const float rstd = rsqrtf(ss * (1.0f / 128.0f) + EPS) * (1.0f - lam_init);
    bf16_t* MX = (bf16_t*)(ws + WS_MIX) + (tokb + t) * DM + 512 + h * 128 + 4 * q;
#pragma unroll
    for (int j = 0; j < 8; ++j) { const f32x4 gn = *(const f32x4*)(I.subln + 16 * j + 4 * q); u32x2 w; w.x = pk2(o0[j][0] * rstd * gn[0], o0[j][1] * rstd * gn[1]); w.y = pk2(o0[j][2] * rstd * gn[2], o0[j][3] * rstd * gn[3]); *(u32x2*)(MX + 16 * j) = w; }
}
struct Args { In in; float* out; unsigned char* ws; int ph_lo, ph_hi; };
constexpr int NPHASE = 17;
__global__ void __launch_bounds__(NWAVES * 64, 2) mk_fwd(Args args) {
    extern __shared__ __attribute__((aligned(16))) unsigned char lds[];
    LAS unsigned char* const L = (LAS unsigned char*)lds;
    volatile LAS unsigned* const MISC = (volatile LAS unsigned*)(L + MISC_OFF);
    const int tid = threadIdx.x, lane = tid & 63, wave = __builtin_amdgcn_readfirstlane(tid >> 6);
    const int G = gridDim.x; const int bx = blockIdx.x; const int vcu = (G % 8 == 0) ? (bx % 8) * (G / 8) + bx / 8 : bx;
    unsigned char* const ws = args.ws; const In& I = args.in; float* const out = args.out;
    gu32* const ctl = (gu32*)(ws + WS_CTL);
    for (int u = tid; u < (LDS_BYTES - LDSCTL_OFF) / 4; u += NWAVES * 64) ((LAS unsigned*)(L + LDSCTL_OFF))[u] = 0u;
    __syncthreads();
    const int lo = args.ph_lo, hi = args.ph_hi;
    XcdBarrier bar; bar.bar = (unsigned*)(ctl + CW_BAR); bar.x = 0; bar.st = nullptr;
    if (hi - lo > 1) bar = xcd_barrier_post((unsigned*)(ctl + CW_BAR), MISC + 8);
#define IN_(k) (lo <= (k) && (k) < hi)
#define SEAM(k) do { if (IN_(k) && IN_((k) + 1)) xcd_barrier(bar); } while (0)
    const int gw = vcu * NWAVES + wave, NGW = G * NWAVES;
    float* const cosr = (float*)(ws + WS_COSR); float* const sinr = (float*)(ws + WS_SINR); float* const cosd = (float*)(ws + WS_COSD); float* const sind = (float*)(ws + WS_SIND);
    float* const cosT = (float*)(ws + WS_COSRT); float* const sinT = (float*)(ws + WS_SINRT); float* const lb0 = (float*)(ws + WS_LB0);
    bf16_t* const XN = (bf16_t*)(ws + WS_XN); bf16_t* const MIX = (bf16_t*)(ws + WS_MIX); bf16_t* const WRT = (bf16_t*)(ws + WS_WROUT);
    int* const LIST = (int*)(ws + WS_LIST); float* const GATEW = (float*)(ws + WS_GATEW); int* const EXPID = (int*)(ws + WS_EXPID); bf16_t* const ACT = (bf16_t*)(ws + WS_ACT); bf16_t* const Y = (bf16_t*)(ws + WS_Y);

    if (IN_(0)) {
        for (int it = gw; it < CV_TOTAL; it += NGW) conv_item(I, ws, it, lane);
        for (int idx = (gw * 64 + lane); idx < T_ * 64; idx += NGW * 64) { const int t = idx >> 6, i = idx & 63; float s, c; nv::sincos_d((double)I.pos[t] * INVR[i], s, c);
            cosr[idx] = c; sinr[idx] = s; cosT[(size_t)i * T_ + t] = c; sinT[(size_t)i * T_ + t] = s;
            if ((i & 1) == 0) { cosd[t * 32 + (i >> 1)] = c; sind[t * 32 + (i >> 1)] = s; } }
        if (bx == 0) { const int idx = tid; const float a = I.lb_logits[idx], b = I.lb_logits[512 + idx], c2 = I.lb_logits[1024 + idx]; const float m = fmaxf(a, fmaxf(b, c2));
            const float ea = expf(a - m), eb = expf(b - m), ec = expf(c2 - m); lb0[idx] = ea / (ea + eb + ec); }
        build_wrt(I, WRT, gw * 64 + lane, NGW * 64);
        for (int m = gw; m < T_; m += NGW) row_op(I.x, nullptr, nullptr, nullptr, I.norm_mix, XN, m, lane);
    }
    SEAM(0);
    if (IN_(1)) {
        { pg8::StaticOrder S; S.init(T_, 3072, DM, G, bx); epi::L0N E{ws, cosr, sinr, lb0};
          pg8::gemm_phase(L + RING_OFF, XN, (const bf16_t*)(ws + WS_WIN0T), DM, S, E); }
        { pg8::StaticOrder S; S.init(1536, T_, DM, G, bx); epi::TR E{ws, cosT, sinT, 0};
          pg8::gemm_phase(L + RING_OFF, (const bf16_t*)(ws + WS_WIN0T) + (size_t)3072 * DM, XN, DM, S, E); }
    }
    SEAM(1);
    if (IN_(2)) { for (int u = vcu; u < 1536; u += G) { if (u < 512) ret_local(L, ws, u, tid, lane, wave); else hg_local(L, ws, u - 512, tid, lane, wave); } }
    SEAM(2);
    if (IN_(3)) { for (int g = bx * 512 + tid; g < 131072; g += G * 512) scan_states(ws, g); }
    SEAM(3);
    if (IN_(4)) { for (int u = vcu; u < 1536; u += G) { if (u < 512) ret_out(L, ws, I.ret_gnorm, u, tid, lane, wave); else hg_out(L, ws, I.hgrn_onorm, u - 512, tid, lane, wave); } }
    SEAM(4);
    if (IN_(5)) { pg8::StaticOrder S; S.init(T_, DM, DM, G, bx); epi::OutRes E{I.x, out}; pg8::gemm_phase(L + RING_OFF, MIX, (const bf16_t*)(ws + WS_WOUT0T), DM, S, E); }
    SEAM(5);
#define MOE_PHASES(l, p6) \
    if (IN_(p6)) { for (int grp = vcu; grp < T_ / 64; grp += G) route_group(L, out, I.norm_ffn + (l) * DM, WRT + (size_t)(l) * WRT_L, I.rgb + (l) * 4, I.reb + (l) * 32, XN, (unsigned*)(ctl + CW_MOE + (l) * 64), LIST, GATEW, EXPID, grp * 64, tid, lane, wave); } \
    SEAM(p6); \
    if (IN_((p6) + 1)) { const MoeTabs tb = moe_tabs(L); moe_build(tb, (const unsigned*)(ctl + CW_MOE + (l) * 64), tid); MoeOrder S{tb, LIST, G, vcu, DM, 1, (size_t)1024 * 1024 * 2}; epi::Moe1 E{ACT}; \
        pg8::gemm_phase(L + RING_OFF, XN, (const bf16_t*)(ws + WS_MOEW + (size_t)(l) * MOE_L_BYTES), DM, S, E); } \
    SEAM((p6) + 1); \
    if (IN_((p6) + 2)) { const MoeTabs tb = moe_tabs(L); moe_build(tb, (const unsigned*)(ctl + CW_MOE + (l) * 64), tid); MoeOrder S{tb, LIST, G, vcu, EFF, 0, (size_t)1024 * 512 * 2}; epi::Moe2 E{Y, LIST, GATEW, tb}; \
        pg8::gemm_phase(L + RING_OFF, ACT, (const bf16_t*)(ws + WS_MOEW + (size_t)(l) * MOE_L_BYTES + MOE_W2_OFF), EFF, S, E); } \
    SEAM((p6) + 2);
    MOE_PHASES(0, 6)
    if (IN_(9)) { for (int m = gw; m < T_; m += NGW) row_op(out, nullptr, Y, out, I.norm_mix + DM, XN, m, lane); }
    SEAM(9);
    if (IN_(10)) {
        { pg8::StaticOrder S; S.init(T_, 2048, DM, G, bx); epi::L1N E{ws, cosd, sind, I.qnorm, I.knorm};
          pg8::gemm_phase(L + RING_OFF, XN, (const bf16_t*)(ws + WS_WIN1T), DM, S, E); }
        { pg8::StaticOrder S; S.init(1024, T_, DM, G, bx); epi::TR E{ws, nullptr, nullptr, 1};
          pg8::gemm_phase(L + RING_OFF, (const bf16_t*)(ws + WS_WIN1T) + (size_t)2048 * DM, XN, DM, S, E); }
    }
    SEAM(10);
    if (IN_(11)) { for (int u = vcu; u < 256; u += G) { const int bh = u >> 4, pr = u & 15;
        for (int k2 = 0; k2 < 2; ++k2) diff_unit(L, ws, I, bh, k2 ? pr : 31 - pr, tid, lane, wave);
        for (int k2 = 0; k2 < 2; ++k2) sb_unit(L, ws, bh, k2 ? pr : 31 - pr, tid, lane, wave); } }
    SEAM(11);
    if (IN_(12)) { pg8::StaticOrder S; S.init(T_, DM, DM, G, bx); epi::OutRes E{out, out}; pg8::gemm_phase(L + RING_OFF, MIX, (const bf16_t*)(ws + WS_WOUT1T), DM, S, E); }
    SEAM(12);
    MOE_PHASES(1, 13)
    if (IN_(16)) { for (int m = gw; m < T_; m += NGW) row_op(out, nullptr, Y, out, nullptr, nullptr, m, lane); }
#undef IN_
#undef SEAM
}
static int g_grid = 0;
static void launch_mk(const In& I, float* out, unsigned char* ws, int lo, int hi, hipStream_t st) {
    Args a{}; a.in = I; a.out = out; a.ws = ws; a.ph_lo = lo; a.ph_hi = hi;
    hipLaunchKernelGGL(mk_fwd, dim3(g_grid), dim3(NWAVES * 64), LDS_BYTES, st, a);
    const hipError_t le = hipPeekAtLastError(); if (le != hipSuccess) fprintf(stderr, "kernel_launch: mk_fwd[%d,%d) failed: %s\n", lo, hi, hipGetErrorName(le));
}
extern "C" void kernel_launch(void* const* d_in, const int* in_sizes, int n_in, void* d_out, int out_size, void* d_ws, size_t ws_size, hipStream_t stream) {
    if (g_grid == 0) {
        if (n_in != 25 || in_sizes[0] != T_ * DM || out_size != T_ * DM || ws_size < WS_END) { fprintf(stderr, "kernel_launch: unexpected shapes (n_in %d, in0 %d, out %d, ws %zu)\n", n_in, n_in > 0 ? in_sizes[0] : -1, out_size, ws_size); g_grid = -1; return; }
        int dev = 0, cus = 0;
        if (hipGetDevice(&dev) != hipSuccess || hipDeviceGetAttribute(&cus, hipDeviceAttributeMultiprocessorCount, dev) != hipSuccess) { g_grid = -1; return; }
        if (hipFuncSetAttribute((const void*)mk_fwd, hipFuncAttributeMaxDynamicSharedMemorySize, LDS_BYTES) != hipSuccess) { fprintf(stderr, "kernel_launch: hipFuncSetAttribute failed\n"); g_grid = -1; return; }
        (void)hipGetLastError();
        g_grid = cus;
    }
    if (g_grid < 0) return;
    In I; I.x = (const float*)d_in[0]; I.pos = (const int*)d_in[1]; I.norm_mix = (const float*)d_in[2]; I.norm_ffn = (const float*)d_in[3]; I.w_in_ab = (const float*)d_in[4]; I.w_out_ab = (const float*)d_in[5];
    I.ret_gnorm = (const float*)d_in[6]; I.lb_logits = (const float*)d_in[7]; I.hgrn_onorm = (const float*)d_in[8]; I.w_in_cd = (const float*)d_in[9]; I.w_out_cd = (const float*)d_in[10];
    I.qnorm = (const float*)d_in[11]; I.knorm = (const float*)d_in[12]; I.lq1 = (const float*)d_in[13]; I.lk1 = (const float*)d_in[14]; I.lq2 = (const float*)d_in[15]; I.lk2 = (const float*)d_in[16]; I.subln = (const float*)d_in[17];
    I.rgw = (const float*)d_in[18]; I.rgb = (const float*)d_in[19]; I.rew = (const float*)d_in[20]; I.reb = (const float*)d_in[21]; I.wgate = (const float*)d_in[22]; I.wup = (const float*)d_in[23]; I.wdown = (const float*)d_in[24];
    unsigned char* ws = (unsigned char*)d_ws; float* out = (float*)d_out; hipStream_t st = stream;
    (void)hipMemsetAsync(ws + WS_CTL, 0, CTL_ZERO_BYTES, st);
    bf16_t* MIX = (bf16_t*)(ws + WS_MIX);
#if defined(PER_PHASE_LAUNCH)
    for (int p = 0; p < NPHASE; ++p) launch_mk(I, out, ws, p, p + 1, st);
#else
    launch_mk(I, out, ws, 0, NPHASE, st);
#endif
}
```
